# Optimizing an MI355X kernel written in HIP

```python
import math
import jax
import jax.numpy as jnp
from jax import lax
import numpy as np

D_MODEL = 1024
BATCH = 16
SEQ = 2048
DEPTH = 4

D_FF = 2816
RMS_EPS = 1e-6

HY_WIDTH = D_MODEL // 2
HY_ORDER = 2
HY_SHORT_CONV = 3
HY_EMB = 33
HY_BANDS = (HY_EMB - 1) // 2
HY_FILTER_HIDDEN = 64
HY_DECAY_TARGET = 1e-2
HY_FAST_DECAY = 0.3
HY_SLOW_DECAY = 1.5
HY_MOD_SHIFT = 0.05
HY_NORM_EPS = 1e-6

ATTN_GROUPS = ((128, 1), (512, 4), (2048, 16))
N_GROUPS = len(ATTN_GROUPS)
HEADS_PER_GROUP = 8
HEAD_DIM = 64
N_ATTN_HEADS = N_GROUPS * HEADS_PER_GROUP
ATTN_WIDTH = HEADS_PER_GROUP * HEAD_DIM
BAND = max(w // (2 * d) for (w, d) in ATTN_GROUPS)
N_BUCKETS = 32
BUCKET_MAX_EXACT = 8
BUCKET_MAX_DIST = 1024
NEG_INF = -1e30

RG_WIDTH = D_MODEL // 2
RG_BLOCKS = 8
RG_BLOCK = RG_WIDTH // RG_BLOCKS
RG_CONV = 4
RG_CONV_LEFT = 2
RG_C = 8.0

N_BRANCH = 3
HY_COLS = (HY_ORDER + 1) * HY_WIDTH
ATTN_QKV_COLS = 3 * N_ATTN_HEADS * HEAD_DIM
RG_COLS = 2 * RG_WIDTH
IN_COLS = HY_COLS + ATTN_QKV_COLS + RG_COLS

kernel_name = "hybrid_hyena_dilated_attn_rglru_macaron"


def rms_norm(x, g):
    xf = x.astype(jnp.float32)
    y = xf * lax.rsqrt(jnp.mean(xf * xf, axis=-1, keepdims=True) + RMS_EPS)
    return (y * g.astype(jnp.float32)).astype(x.dtype)


def swiglu(x, wg, wu, wd):
    return (jax.nn.silu(x @ wg) * (x @ wu)) @ wd


def depthwise_conv(x, w, b, pad_left):
    K = w.shape[0]
    S = x.shape[1]
    xp = jnp.pad(x, ((0, 0), (pad_left, K - 1 - pad_left), (0, 0)))
    return sum(xp[:, k:k + S] * w[k] for k in range(K)) + b


def hyena_filter_spectra(L, w1, b1, w2, b2, w3, b3, freq, wout):
    f32 = jnp.float32
    t = jnp.linspace(0.0, 1.0, L, dtype=f32)[:, None]
    tr = jnp.arange(L, dtype=f32)[:, None]
    wpos = 2.0 * math.pi * tr / L
    fb = jnp.linspace(1e-4, HY_BANDS - 1, HY_BANDS, dtype=f32)[None, :]
    z = jnp.concatenate([t, jnp.cos(fb * wpos), -jnp.sin(fb * wpos)], axis=-1)
    fr = freq.astype(f32)
    hdn = jnp.sin(fr * (z @ w1.astype(f32) + b1.astype(f32)))
    hdn = jnp.sin(fr * (hdn @ w2.astype(f32) + b2.astype(f32)))
    hdn = jnp.sin(fr * (hdn @ w3.astype(f32) + b3.astype(f32)))
    h = (hdn @ wout.astype(f32)).reshape(L, 2, HY_ORDER, HY_WIDTH)
    deltas = jnp.abs(jnp.linspace(math.log(HY_DECAY_TARGET) / HY_FAST_DECAY,
                                  math.log(HY_DECAY_TARGET) / HY_SLOW_DECAY,
                                  HY_WIDTH, dtype=f32))
    decay = jnp.exp(-t * deltas[None, :]) + HY_MOD_SHIFT
    h = h * decay[:, None, None, :]
    kf = h[:, 0]
    kb = h[:, 1]
    K = jnp.concatenate([kf, jnp.zeros((1, HY_ORDER, HY_WIDTH), f32), kb[:0:-1]], axis=0)
    K = K / (jnp.sum(jnp.abs(K), axis=0, keepdims=True) + HY_NORM_EPS)
    return jnp.fft.rfft(K, axis=0)


def fft_long_conv(z, kf_spec):
    L = z.shape[1]
    Z = jnp.fft.rfft(z.astype(jnp.float32), n=2 * L, axis=1)
    y = jnp.fft.irfft(Z * kf_spec[None], n=2 * L, axis=1)[:, :L]
    return y.astype(z.dtype)


def t5_bucket(rel):
    half = N_BUCKETS // 2
    ret = jnp.where(rel > 0, half, 0)
    n = jnp.abs(rel)
    nf = jnp.maximum(n, 1).astype(jnp.float32)
    large = BUCKET_MAX_EXACT + (jnp.log(nf / BUCKET_MAX_EXACT)
                                / math.log(BUCKET_MAX_DIST / BUCKET_MAX_EXACT)
                                * (half - BUCKET_MAX_EXACT)).astype(jnp.int32)
    large = jnp.minimum(large, half - 1)
    return ret + jnp.where(n < BUCKET_MAX_EXACT, n, large)


def dilated_band_attention(q, k, v, dilation, half_span, bias_table):
    B, S, H, E = q.shape
    d = dilation
    Ls = S // d
    nb = -(-Ls // BAND)
    Lp = nb * BAND

    def to_sub(t):
        return t.reshape(B, Ls, d, H, E).transpose(0, 2, 3, 1, 4)

    pad_q = ((0, 0), (0, 0), (0, 0), (0, Lp - Ls), (0, 0))
    pad_k = ((0, 0), (0, 0), (0, 0), (BAND, Lp - Ls + BAND), (0, 0))
    qs = jnp.pad(to_sub(q), pad_q).reshape(B, d, H, nb, BAND, E)
    ks = jnp.pad(to_sub(k), pad_k).reshape(B, d, H, nb + 2, BAND, E)
    vs = jnp.pad(to_sub(v), pad_k).reshape(B, d, H, nb + 2, BAND, E)
    kb = jnp.concatenate([ks[:, :, :, 0:nb], ks[:, :, :, 1:nb + 1], ks[:, :, :, 2:nb + 2]], axis=-2)
    vb = jnp.concatenate([vs[:, :, :, 0:nb], vs[:, :, :, 1:nb + 1], vs[:, :, :, 2:nb + 2]], axis=-2)

    s = jnp.einsum('bdhnqe,bdhnke->bdhnqk', qs, kb,
                   preferred_element_type=jnp.float32) * (HEAD_DIM ** -0.5)
    qi = jnp.arange(BAND, dtype=jnp.int32)[:, None]
    kj = jnp.arange(3 * BAND, dtype=jnp.int32)[None, :]
    delta = kj - BAND - qi
    key_idx = jnp.arange(nb, dtype=jnp.int32)[:, None, None] * BAND + kj[None] - BAND
    valid = (jnp.abs(delta)[None] <= half_span) & (key_idx >= 0) & (key_idx < Ls)
    bias = bias_table.astype(jnp.float32)[t5_bucket(delta * d)]
    s = s + jnp.transpose(bias, (2, 0, 1))[None, None, :, None]
    s = jnp.where(valid[None, None, None], s, NEG_INF)
    m = jnp.max(s, axis=-1, keepdims=True)
    p = jnp.exp(s - m)
    den = jnp.sum(p, axis=-1)
    o = jnp.einsum('bdhnqk,bdhnke->bdhnqe', p, vb.astype(jnp.float32)) / den[..., None]
    lse = m[..., 0] + jnp.log(den)

    o = o.reshape(B, d, H, Lp, E)[:, :, :, :Ls].transpose(0, 3, 1, 2, 4).reshape(B, S, H, E)
    lse = lse.reshape(B, d, H, Lp)[:, :, :, :Ls].transpose(0, 3, 1, 2).reshape(B, S, H)
    return o, lse


def rg_lru_scan(xc, wa, ba, wx, bx, lam):
    B, S, _ = xc.shape
    xb = xc.reshape(B, S, RG_BLOCKS, RG_BLOCK)
    r = jax.nn.sigmoid(jnp.einsum('bshi,hij->bshj', xb, wa).reshape(B, S, RG_WIDTH) + ba)
    gi = jax.nn.sigmoid(jnp.einsum('bshi,hij->bshj', xb, wx).reshape(B, S, RG_WIDTH) + bx)
    log_a = -RG_C * r.astype(jnp.float32) * jax.nn.softplus(-lam.astype(jnp.float32))
    a = jnp.exp(log_a)
    u = jnp.sqrt(-jnp.expm1(2.0 * log_a)) * (gi * xc).astype(jnp.float32)

    def combine(e1, e2):
        a1, b1 = e1
        a2, b2 = e2
        return a1 * a2, a2 * b1 + b2

    _, h = lax.associative_scan(combine, (a, u), axis=1)
    return h


def hybrid_mixer(xn, w_in, hy_conv_w, hy_conv_b, hy_w1, hy_b1, hy_w2, hy_b2, hy_w3, hy_b3,
                 hy_freq, hy_wout, hy_skip, rel_bias, rg_conv_w, rg_conv_b, rg_wa, rg_ba,
                 rg_wx, rg_bx, rg_lambda, w_gate, b_gate, w_proj_hy, w_proj_attn, w_proj_rg, w_out):
    B, S, _ = xn.shape
    proj = xn @ w_in
    u_hy = proj[..., :HY_COLS]
    qkv = proj[..., HY_COLS:HY_COLS + ATTN_QKV_COLS]
    u_rg = proj[..., HY_COLS + ATTN_QKV_COLS:]

    uc = depthwise_conv(u_hy, hy_conv_w, hy_conv_b, (HY_SHORT_CONV - 1) // 2)
    v_hy = uc[..., :HY_WIDTH]
    gates_hy = (uc[..., HY_WIDTH:2 * HY_WIDTH], uc[..., 2 * HY_WIDTH:])
    spec = hyena_filter_spectra(S, hy_w1, hy_b1, hy_w2, hy_b2, hy_w3, hy_b3, hy_freq, hy_wout)
    z = v_hy
    for o in range(HY_ORDER):
        z = gates_hy[o] * (fft_long_conv(z, spec[:, o]) + hy_skip[o] * z)
    y_a = z

    qkv = qkv.reshape(B, S, 3, N_GROUPS, HEADS_PER_GROUP, HEAD_DIM)
    outs = []
    lses = []
    for g, (win, dil) in enumerate(ATTN_GROUPS):
        o_g, l_g = dilated_band_attention(
            qkv[:, :, 0, g], qkv[:, :, 1, g], qkv[:, :, 2, g], dil, win // (2 * dil),
            rel_bias[:, g * HEADS_PER_GROUP:(g + 1) * HEADS_PER_GROUP])
        outs.append(o_g)
        lses.append(l_g)
    wts = jax.nn.softmax(jnp.stack(lses, axis=-1), axis=-1)
    o_att = jnp.einsum('gbshe,bshg->bshe', jnp.stack(outs, axis=0), wts)
    y_b = o_att.reshape(B, S, ATTN_WIDTH).astype(xn.dtype)

    x_rg = u_rg[..., :RG_WIDTH]
    gate_rg = u_rg[..., RG_WIDTH:]
    xc = depthwise_conv(x_rg, rg_conv_w, rg_conv_b, RG_CONV_LEFT)
    h_f = rg_lru_scan(xc, rg_wa[0], rg_ba[0], rg_wx[0], rg_bx[0], rg_lambda[0])
    h_b = jnp.flip(rg_lru_scan(jnp.flip(xc, axis=1), rg_wa[1], rg_ba[1], rg_wx[1],
                               rg_bx[1], rg_lambda[1]), axis=1)
    y_c = (h_f + h_b).astype(xn.dtype) * jax.nn.gelu(gate_rg)

    gates = jax.nn.sigmoid(xn @ w_gate + b_gate).reshape(B, S, N_BRANCH, D_MODEL)
    merged = (gates[:, :, 0] * (y_a @ w_proj_hy)
              + gates[:, :, 1] * (y_b @ w_proj_attn)
              + gates[:, :, 2] * (y_c @ w_proj_rg))
    return merged @ w_out


def setup_inputs(seed: int = 0) -> dict:
    key = jax.random.key(seed)
    ks = iter(jax.random.split(key, 64))
    f32 = jnp.float32
    L = DEPTH

    def nrm(shape, scale):
        return jax.random.normal(next(ks), shape, f32) * scale

    def gain(shape):
        return 1.0 + nrm(shape, 0.05)

    lam_u = jax.random.uniform(next(ks), (L, 2, RG_WIDTH), f32, 0.9, 0.999) ** (1.0 / RG_C)
    inputs = {
        "x": nrm((BATCH, SEQ, D_MODEL), 1.0),
        "ffn1_norm": gain((L, D_MODEL)),
        "ffn1_wg": nrm((L, D_MODEL, D_FF), D_MODEL ** -0.5),
        "ffn1_wu": nrm((L, D_MODEL, D_FF), D_MODEL ** -0.5),
        "ffn1_wd": nrm((L, D_FF, D_MODEL), D_FF ** -0.5),
        "mix_norm": gain((L, D_MODEL)),
        "w_in": nrm((L, D_MODEL, IN_COLS), D_MODEL ** -0.5),
        "hy_conv_w": nrm((L, HY_SHORT_CONV, HY_COLS), HY_SHORT_CONV ** -0.5),
        "hy_conv_b": nrm((L, HY_COLS), 0.02),
        "hy_w1": nrm((L, HY_EMB, HY_FILTER_HIDDEN), HY_EMB ** -0.5),
        "hy_b1": nrm((L, HY_FILTER_HIDDEN), 0.1),
        "hy_w2": nrm((L, HY_FILTER_HIDDEN, HY_FILTER_HIDDEN), HY_FILTER_HIDDEN ** -0.5),
        "hy_b2": nrm((L, HY_FILTER_HIDDEN), 0.1),
        "hy_w3": nrm((L, HY_FILTER_HIDDEN, HY_FILTER_HIDDEN), HY_FILTER_HIDDEN ** -0.5),
        "hy_b3": nrm((L, HY_FILTER_HIDDEN), 0.1),
        "hy_freq": gain((L, HY_FILTER_HIDDEN)),
        "hy_wout": nrm((L, HY_FILTER_HIDDEN, 2 * HY_ORDER * HY_WIDTH), HY_FILTER_HIDDEN ** -0.5),
        "hy_skip": nrm((L, HY_ORDER, HY_WIDTH), 0.5),
        "rel_bias": nrm((N_BUCKETS, N_ATTN_HEADS), 0.2),
        "rg_conv_w": nrm((L, RG_CONV, RG_WIDTH), RG_CONV ** -0.5),
        "rg_conv_b": nrm((L, RG_WIDTH), 0.02),
        "rg_wa": nrm((L, 2, RG_BLOCKS, RG_BLOCK, RG_BLOCK), RG_BLOCK ** -0.5),
        "rg_ba": nrm((L, 2, RG_WIDTH), 0.02),
        "rg_wx": nrm((L, 2, RG_BLOCKS, RG_BLOCK, RG_BLOCK), RG_BLOCK ** -0.5),
        "rg_bx": nrm((L, 2, RG_WIDTH), 0.02),
        "rg_lambda": jnp.log(lam_u / (1.0 - lam_u)),
        "w_gate": nrm((L, D_MODEL, N_BRANCH * D_MODEL), D_MODEL ** -0.5),
        "b_gate": nrm((L, N_BRANCH * D_MODEL), 0.02),
        "w_proj_hy": nrm((L, HY_WIDTH, D_MODEL), HY_WIDTH ** -0.5),
        "w_proj_attn": nrm((L, ATTN_WIDTH, D_MODEL), ATTN_WIDTH ** -0.5),
        "w_proj_rg": nrm((L, RG_WIDTH, D_MODEL), RG_WIDTH ** -0.5),
        "w_out": nrm((L, D_MODEL, D_MODEL), D_MODEL ** -0.5),
        "ffn2_norm": gain((L, D_MODEL)),
        "ffn2_wg": nrm((L, D_MODEL, D_FF), D_MODEL ** -0.5),
        "ffn2_wu": nrm((L, D_MODEL, D_FF), D_MODEL ** -0.5),
        "ffn2_wd": nrm((L, D_FF, D_MODEL), D_FF ** -0.5),
        "final_norm": gain((D_MODEL,)),
    }
    return inputs


def reference(x, ffn1_norm, ffn1_wg, ffn1_wu, ffn1_wd, mix_norm, w_in, hy_conv_w, hy_conv_b,
              hy_w1, hy_b1, hy_w2, hy_b2, hy_w3, hy_b3, hy_freq, hy_wout, hy_skip, rel_bias,
              rg_conv_w, rg_conv_b, rg_wa, rg_ba, rg_wx, rg_bx, rg_lambda, w_gate, b_gate,
              w_proj_hy, w_proj_attn, w_proj_rg, w_out, ffn2_norm, ffn2_wg, ffn2_wu, ffn2_wd,
              final_norm):
    h = x
    for l in range(DEPTH):
        h = h + 0.5 * swiglu(rms_norm(h, ffn1_norm[l]), ffn1_wg[l], ffn1_wu[l], ffn1_wd[l])
        h = h + hybrid_mixer(
            rms_norm(h, mix_norm[l]), w_in[l], hy_conv_w[l], hy_conv_b[l],
            hy_w1[l], hy_b1[l], hy_w2[l], hy_b2[l], hy_w3[l], hy_b3[l], hy_freq[l], hy_wout[l],
            hy_skip[l], rel_bias, rg_conv_w[l], rg_conv_b[l], rg_wa[l], rg_ba[l], rg_wx[l],
            rg_bx[l], rg_lambda[l], w_gate[l], b_gate[l], w_proj_hy[l], w_proj_attn[l],
            w_proj_rg[l], w_out[l])
        h = h + 0.5 * swiglu(rms_norm(h, ffn2_norm[l]), ffn2_wg[l], ffn2_wu[l], ffn2_wd[l])
    return rms_norm(h, final_norm)
```

```cpp
#include <hip/hip_runtime.h>
#include <hip/hip_cooperative_groups.h>
#include <stdint.h>
#include <cstdio>
namespace cg = cooperative_groups;

#define LAS __attribute__((address_space(3)))
typedef unsigned short bf16_t;
typedef short bf16x8 __attribute__((ext_vector_type(8)));
typedef float f32x4 __attribute__((ext_vector_type(4)));
typedef unsigned u32x4 __attribute__((ext_vector_type(4)));
typedef unsigned u32x2 __attribute__((ext_vector_type(2)));

constexpr int DM = 1024, NB = 16, SEQ = 2048, MT = NB * SEQ, DEPTH = 4, DFF = 2816;
constexpr int HYW = 512, HYC = 1536, QKVC = 4608, RGW = 512, INC = 7168;
constexpr int MC = MT / 2;
constexpr size_t MiB = 1u << 20;
constexpr size_t W_UP1 = 0, W_DN1 = W_UP1 + 5632ull * 1024, W_HYRG = W_DN1 + 1024ull * 2816, W_QKV = W_HYRG + 2560ull * 1024,
                 W_GATE = W_QKV + 4608ull * 1024, W_PCAT = W_GATE + 3072ull * 1024,
                 W_OUT = W_PCAT + 1024ull * 1536, W_UP2 = W_OUT + 1024ull * 1024, W_DN2 = W_UP2 + 5632ull * 1024, W_RG = W_DN2 + 1024ull * 2816,
                 W_END = W_RG + 2048ull * 512;
static_assert(W_END == 30ull * 1024 * 1024, "weights");
constexpr size_t OFF_WT = 0;
constexpr size_t OFF_XN = OFF_WT + 60 * MiB;
constexpr size_t OFF_A = OFF_XN + 64 * MiB;
constexpr size_t OFF_B = OFF_A + 176 * MiB;
constexpr size_t OFF_XC = OFF_B + 128 * MiB;
constexpr size_t OFF_YA = OFF_XC + 32 * MiB, OFF_YB = OFF_YA + 32 * MiB, OFF_YC = OFF_YB + 32 * MiB;
constexpr size_t OFF_SM = OFF_YC + 32 * MiB;
constexpr size_t OFF_PART = OFF_SM + 1 * MiB;
constexpr size_t OFF_HDN = OFF_PART + 2 * MiB;
constexpr size_t WS_NEED = OFF_HDN + 1 * MiB;
constexpr int LDS_BYTES = 144 * 1024;
#ifndef REP
#define REP 0
#endif
#define RP(bit) for (int rp_ = 0; rp_ < (((REP >> (bit)) & 1) ? 2 : 1); ++rp_)

struct Params { const float* in[37]; float* out; unsigned char* ws; };

__device__ __forceinline__ int tid_opaque() { int t = threadIdx.x; asm volatile("" : "+v"(t)); return t; }
#define TIDX tid_opaque()
__device__ __forceinline__ u32x4 zero4() { unsigned z = 0; asm volatile("" : "+v"(z)); return (u32x4){z, z, z, z}; }
extern __shared__ __attribute__((aligned(16))) unsigned char g_smem[];
constexpr int PTR_OFF = LDS_BYTES - 512;
__device__ __forceinline__ const void* ldp(int i) {
    const unsigned long long v = *(const volatile unsigned long long*)(g_smem + PTR_OFF + 8 * i);
    const unsigned lo = __builtin_amdgcn_readfirstlane((unsigned)v), hi = __builtin_amdgcn_readfirstlane((unsigned)(v >> 32));
    return (const void*)(const __attribute__((address_space(1))) void*)(((unsigned long long)hi << 32) | lo);
}
__device__ __forceinline__ bf16_t f2bf(float f) { unsigned u = __float_as_uint(f); u += 0x7FFFu + ((u >> 16) & 1u); return (bf16_t)(u >> 16); }
__device__ __forceinline__ float bf2f(bf16_t b) { return __uint_as_float(((unsigned)b) << 16); }
typedef float f32x2_t __attribute__((ext_vector_type(2)));
typedef __bf16 bf16x2_t __attribute__((ext_vector_type(2)));
__device__ __forceinline__ unsigned cvt_pk_bf16(float lo, float hi) { const f32x2_t v = {lo, hi}; const bf16x2_t b = __builtin_convertvector(v, bf16x2_t); return __builtin_bit_cast(unsigned, b); }
__device__ __forceinline__ float lo_bf(unsigned w) { return __uint_as_float(w << 16); }
__device__ __forceinline__ float hi_bf(unsigned w) { return __uint_as_float(w & 0xffff0000u); }
__device__ __forceinline__ float sigmoidf_(float x) { return __builtin_amdgcn_rcpf(1.0f + __builtin_amdgcn_exp2f(-1.4426950408889634f * x)); }
__device__ __forceinline__ float sin_acc(float x, double shift) {
    double xd = (double)x + shift; const double k = rint(xd * 0.15915494309189535); double r = xd - k * 6.283185307179586;
    const double r2 = r * r; double s = -1.0 / 51090942171709440000.0;
    s = s * r2 + 1.0 / 121645100408832000.0; s = s * r2 - 1.0 / 355687428096000.0; s = s * r2 + 1.0 / 1307674368000.0; s = s * r2 - 1.0 / 6227020800.0;
    s = s * r2 + 1.0 / 39916800.0; s = s * r2 - 1.0 / 362880.0; s = s * r2 + 1.0 / 5040.0; s = s * r2 - 1.0 / 120.0; s = s * r2 + 1.0 / 6.0;
    return (float)(r - r * r2 * s);
}

namespace pg8 {
constexpr int BM = 256, BK = 64, HALF = 128, HTB = HALF * BK * 2, STAGE_BYTES = 8 * HTB, NXCD = 8, WGM = 8;
__host__ __device__ __forceinline__ int lds_byte(int r, int c) { const int st = (r >> 4) * 2 + (c >> 5), rr = r & 15, cc = c & 31, ob = rr * 64 + cc * 2; return st * 1024 + (ob ^ (((ob >> 9) & 1) << 5)); }
__host__ __device__ __forceinline__ void stage_rc(int b, int& R, int& C) { const int st = b / 1024, sb = b % 1024, swz = sb ^ (((sb >> 9) & 1) << 5); R = (st >> 1) * 16 + swz / 64; C = (st & 1) * 32 + (swz % 64) / 2; }
__host__ __device__ __forceinline__ int perm32(int rho) { const int n = rho >> 4, i = rho & 15; return 8 * (i >> 2) + 4 * n + (i & 3); }
struct Unit { int pm, pn; };
struct Gemm { const bf16_t* A; const bf16_t* Bt; int M, N, K; };
struct StaticOrder {
    int nM, nN, nwg, G, c;
    __device__ void init(int M, int N, int G_, int c_) { nM = M / BM; nN = N / BM; nwg = nM * nN; G = G_; c = c_; }
    __device__ bool next(int i, Unit& u) const {
        const long L = (long)i * G + c; if (L >= nwg) return false;
        int wgid = (int)L; { const int q = nwg / NXCD, r = nwg % NXCD, xcd = wgid % NXCD, off = wgid / NXCD; wgid = (xcd < r ? xcd * (q + 1) : r * (q + 1) + (xcd - r) * q) + off; }
        const int nig = WGM * nN, gid = wgid / nig, fm = gid * WGM, gsz = (nM - fm) < WGM ? (nM - fm) : WGM;
        u.pm = fm + ((wgid % nig) % gsz); u.pn = (wgid % nig) / gsz; return true;
    }
};

template <class Epi>
__device__ __forceinline__ void gemm_phase(LAS unsigned char* lds, const Gemm g, const StaticOrder& S, const Epi& E, const bool perm) {
    const int tid = TIDX, wid = __builtin_amdgcn_readfirstlane(tid >> 6), lane = tid & 63, wr = wid >> 2, wc = wid & 3, fr = lane & 15, fq = lane >> 4;
    const int K = g.K, nt = K / BK;
    unsigned voffA[2], voffB[2];
#pragma unroll
    for (int i = 0; i < 2; ++i) { int R, C; stage_rc(tid * 16 + i * 8192, R, C); const int Rb = perm ? ((R & ~31) + perm32(R & 31)) : R;
        voffA[i] = (unsigned)(R * K + C) * 2u; voffB[i] = (unsigned)(Rb * K + C) * 2u; }
    const size_t kstep = (size_t)(BK * 2);
    const size_t hstep = (size_t)HALF * K * 2;
    const size_t tstep = 2 * hstep;
    const unsigned ldsw = (unsigned)wid * 1024u;
    const int aoff = lds_byte(wr * 64 + fr, fq * 8), boff = lds_byte(wc * 32 + fr, fq * 8);
#define PG8_SA(b, h) (((b) * 2 + (h)) * HTB)
#define PG8_SB(b, h) ((4 + (b) * 2 + (h)) * HTB)
#define PG8_STAGE(bufoff, gbase, voff) do { _Pragma("unroll") for (int _i = 0; _i < 2; ++_i) \
        __builtin_amdgcn_global_load_lds((const unsigned*)((const char*)(gbase) + (voff)[_i]), (LAS unsigned*)(lds + (bufoff) + ldsw + _i * 8192), 16, 0, 0); } while (0)
#define PG8_LDA(dst, b, h) do { _Pragma("unroll") for (int m = 0; m < 4; ++m) _Pragma("unroll") for (int k = 0; k < 2; ++k) dst[m][k] = *(const LAS bf16x8*)(lds + PG8_SA(b, h) + aoff + m * 2048 + k * 1024); } while (0)
#define PG8_LDB(dst, b, h) do { _Pragma("unroll") for (int n = 0; n < 2; ++n) _Pragma("unroll") for (int k = 0; k < 2; ++k) dst[n][k] = *(const LAS bf16x8*)(lds + PG8_SB(b, h) + boff + n * 2048 + k * 1024); } while (0)
#define PG8_MMA(ai, bj, At, Bt) do { __builtin_amdgcn_s_setprio(1); _Pragma("unroll") for (int m = 0; m < 4; ++m) _Pragma("unroll") for (int n = 0; n < 2; ++n) _Pragma("unroll") for (int k = 0; k < 2; ++k) \
        acc[ai][bj][m][n] = __builtin_amdgcn_mfma_f32_16x16x32_bf16(Bt[n][k], At[m][k], acc[ai][bj][m][n], 0, 0, 0); __builtin_amdgcn_s_setprio(0); } while (0)
#define PG8_WAIT_V(n) asm volatile("s_waitcnt vmcnt(" #n ")" ::: "memory")
#define PG8_WAIT_L(n) asm volatile("s_waitcnt lgkmcnt(" #n ")" ::: "memory")
#define PG8_BAR __builtin_amdgcn_s_barrier()
#define PG8_SCHED __builtin_amdgcn_sched_barrier(0)
    Unit cur, nxt; int ui = 0;
    if (!S.next(0, cur)) return;
    f32x4 acc[2][2][4][2];
#pragma unroll
    for (int a = 0; a < 2; ++a)
#pragma unroll
        for (int b = 0; b < 2; ++b)
#pragma unroll
            for (int m = 0; m < 4; ++m)
#pragma unroll
                for (int n = 0; n < 2; ++n) acc[a][b][m][n] = (f32x4){0.f, 0.f, 0.f, 0.f};
    bf16x8 At[4][2], B0[2][2], B1[2][2];
    const char* cA = (const char*)g.A + (size_t)cur.pm * tstep; const char* cB = (const char*)g.Bt + (size_t)cur.pn * tstep;
    PG8_STAGE(PG8_SB(0, 0), cB, voffB); PG8_STAGE(PG8_SA(0, 0), cA, voffA); PG8_STAGE(PG8_SB(0, 1), cB + hstep, voffB); PG8_STAGE(PG8_SA(0, 1), cA + hstep, voffA);
    if (wr == 1) PG8_BAR;
    PG8_WAIT_V(4); PG8_BAR;
    PG8_STAGE(PG8_SB(1, 0), cB + kstep, voffB); PG8_STAGE(PG8_SA(1, 0), cA + kstep, voffA); PG8_STAGE(PG8_SB(1, 1), cB + hstep + kstep, voffB);
    PG8_WAIT_V(6); PG8_BAR;
    for (;;) {
        const bool has_next = S.next(ui + 1, nxt);
        const char* nA = has_next ? (const char*)g.A + (size_t)nxt.pm * tstep : cA; const char* nB = has_next ? (const char*)g.Bt + (size_t)nxt.pn * tstep : cB;
        for (int t = 0; t < nt; t += 2) {
            if (E.hook() && (t == 8 || t == 16)) E.rescale(acc, cur, t >> 4, wr, wc, fr, fq);
            const bool last = (t == nt - 2);
            const char* a1 = cA + (size_t)(t + 1) * kstep;
            const char* a2 = last ? nA : cA + (size_t)(t + 2) * kstep; const char* b2 = last ? nB : cB + (size_t)(t + 2) * kstep;
            const char* a3 = a2 + kstep; const char* b3 = b2 + kstep;
            PG8_LDB(B0, 0, 0); PG8_SCHED; PG8_LDA(At, 0, 0); PG8_STAGE(PG8_SA(1, 1), a1 + hstep, voffA);
            PG8_WAIT_L(8); PG8_BAR; PG8_WAIT_L(0); PG8_MMA(0, 0, At, B0); PG8_BAR; PG8_SCHED;
            PG8_LDB(B1, 0, 1); PG8_STAGE(PG8_SB(0, 0), b2, voffB);
            PG8_BAR; PG8_WAIT_L(0); PG8_MMA(0, 1, At, B1); PG8_BAR;
            PG8_LDA(At, 0, 1); PG8_STAGE(PG8_SA(0, 0), a2, voffA);
            PG8_BAR; PG8_WAIT_L(0); PG8_MMA(1, 0, At, B0); PG8_BAR; PG8_SCHED;
            PG8_STAGE(PG8_SB(0, 1), b2 + hstep, voffB);
            PG8_WAIT_V(6); PG8_BAR; PG8_MMA(1, 1, At, B1); PG8_BAR;
            PG8_LDB(B0, 1, 0); PG8_SCHED; PG8_LDA(At, 1, 0); PG8_STAGE(PG8_SA(0, 1), a2 + hstep, voffA);
            PG8_WAIT_L(8); PG8_BAR; PG8_WAIT_L(0); PG8_MMA(0, 0, At, B0); PG8_BAR; PG8_SCHED;
            PG8_LDB(B1, 1, 1); PG8_STAGE(PG8_SB(1, 0), b3, voffB);
            PG8_BAR; PG8_WAIT_L(0); PG8_MMA(0, 1, At, B1); PG8_BAR;
            PG8_LDA(At, 1, 1); PG8_STAGE(PG8_SA(1, 0), a3, voffA);
            PG8_BAR; PG8_WAIT_L(0); PG8_MMA(1, 0, At, B0); PG8_BAR; PG8_SCHED;
            PG8_STAGE(PG8_SB(1, 1), b3 + hstep, voffB);
            PG8_WAIT_V(6); PG8_BAR; PG8_MMA(1, 1, At, B1); PG8_BAR;
        }
        E(acc, cur, ui, wr, wc, fr, fq);
        if (!has_next) break;
#pragma unroll
        for (int a = 0; a < 2; ++a)
#pragma unroll
            for (int b = 0; b < 2; ++b)
#pragma unroll
                for (int m = 0; m < 4; ++m)
#pragma unroll
                    for (int n = 0; n < 2; ++n) acc[a][b][m][n] = (f32x4){0.f, 0.f, 0.f, 0.f};
        cur = nxt; cA = nA; cB = nB; ++ui;
    }
    PG8_WAIT_V(0);
    if (wr == 0) PG8_BAR;
    PG8_BAR;
#undef PG8_SA
#undef PG8_SB
#undef PG8_STAGE
#undef PG8_LDA
#undef PG8_LDB
#undef PG8_MMA
#undef PG8_WAIT_V
#undef PG8_WAIT_L
#undef PG8_BAR
#undef PG8_SCHED
}
}
using pg8::Unit; using pg8::HALF; using pg8::BM;
typedef const f32x4 (&AccRef)[2][2][4][2];

constexpr int RT_OFF = 128 * 1024;
__device__ __forceinline__ void row_scales(const LAS float* rt, int lrow0, float (&rr)[2][4]) {
#pragma unroll
    for (int ai = 0; ai < 2; ++ai)
#pragma unroll
        for (int m = 0; m < 4; ++m) rr[ai][m] = rt[lrow0 + ai * HALF + m * 16];
}
struct EpiSwiGLU {
    static constexpr bool PERM = false;
    bf16_t* act; const LAS float* part;
    __device__ __forceinline__ void operator()(AccRef acc, const Unit& u, int wr, int wc, int fr, int fq) const {
        const int row0 = u.pm * BM + wr * 64 + fr;
        float rr[2][4]; row_scales(part, wr * 64 + fr, rr);
#pragma unroll
        for (int ai = 0; ai < 2; ++ai)
#pragma unroll
            for (int m = 0; m < 4; ++m) { bf16_t* rowp = act + (size_t)(row0 + ai * HALF + m * 16) * DFF; const float rs = rr[ai][m];
#pragma unroll
                for (int bj = 0; bj < 2; ++bj) { const int ac = (u.pn * BM + bj * HALF + wc * 32) / 2 + 4 * fq;
                    const f32x4 gg = acc[ai][bj][m][0], uu = acc[ai][bj][m][1]; float o[4]; const float rs2 = rs * rs, nrs = -1.4426950408889634f * rs;
#pragma unroll
                    for (int i = 0; i < 4; ++i) o[i] = (rs2 * gg[i]) * uu[i] * __builtin_amdgcn_rcpf(1.0f + __builtin_amdgcn_exp2f(nrs * gg[i]));
                    u32x2 w; w.x = cvt_pk_bf16(o[0], o[1]); w.y = cvt_pk_bf16(o[2], o[3]); *(u32x2*)(rowp + ac) = w; } }
    }
};
struct EpiResid {
    static constexpr bool PERM = true;
    float* h; float scale; bf16_t* hb; float* part;
    __device__ __forceinline__ void operator()(AccRef acc, const Unit& u, int wr, int wc, int fr, int fq) const {
        const int row0 = u.pm * BM + wr * 64 + fr, col0 = u.pn * BM + wc * 32 + 8 * fq;
#pragma unroll
        for (int ai = 0; ai < 2; ++ai)
#pragma unroll
          for (int mp = 0; mp < 2; ++mp) {
            f32x4 hv[2][2][2];
#pragma unroll
            for (int mm = 0; mm < 2; ++mm) { const float* rowp = h + (size_t)(row0 + ai * HALF + (mp * 2 + mm) * 16) * DM + col0;
#pragma unroll
                for (int bj = 0; bj < 2; ++bj) { hv[mm][bj][0] = __builtin_nontemporal_load((const f32x4*)(rowp + bj * HALF)); hv[mm][bj][1] = __builtin_nontemporal_load((const f32x4*)(rowp + bj * HALF + 4)); } }
#pragma unroll
            for (int mm = 0; mm < 2; ++mm) { const int m = mp * 2 + mm; const size_t row = (size_t)(row0 + ai * HALF + m * 16); float* rowp = h + row * DM + col0; bf16_t* rowb = hb + row * DM + col0; float ss = 0.f;
#pragma unroll
                for (int bj = 0; bj < 2; ++bj) { const f32x4 a = hv[mm][bj][0] + acc[ai][bj][m][0] * scale, b = hv[mm][bj][1] + acc[ai][bj][m][1] * scale;
                    __builtin_nontemporal_store(a, (f32x4*)(rowp + bj * HALF)); __builtin_nontemporal_store(b, (f32x4*)(rowp + bj * HALF + 4));
                    ss += (a[0] * a[0] + a[1] * a[1]) + (a[2] * a[2] + a[3] * a[3]) + (b[0] * b[0] + b[1] * b[1]) + (b[2] * b[2] + b[3] * b[3]);
                    u32x4 w; w.x = cvt_pk_bf16(a[0], a[1]); w.y = cvt_pk_bf16(a[2], a[3]); w.z = cvt_pk_bf16(b[0], b[1]); w.w = cvt_pk_bf16(b[2], b[3]);
                    *(u32x4*)(rowb + bj * HALF) = w; }
                ss += __shfl_xor(ss, 16); ss += __shfl_xor(ss, 32);
                if (fq == 0) part[row * 16 + u.pn * 4 + wc] = ss; } }
    }
};
struct EpiBf16Split {
    static constexpr bool PERM = true;
    bf16_t* O0; int ld0; bf16_t* O1; int ld1; int split; const LAS float* part;
    __device__ __forceinline__ void operator()(AccRef acc, const Unit& u, int wr, int wc, int fr, int fq) const {
        const int row0 = u.pm * BM + wr * 64 + fr; int colt = u.pn * BM; bf16_t* base = O0; int ld = ld0;
        float rr[2][4]; row_scales(part, wr * 64 + fr, rr);
        if (colt >= split) { base = O1; ld = ld1; colt -= split; }
        const int col0 = colt + wc * 32 + 8 * fq;
#pragma unroll
        for (int ai = 0; ai < 2; ++ai)
#pragma unroll
            for (int m = 0; m < 4; ++m) { bf16_t* rowp = base + (size_t)(row0 + ai * HALF + m * 16) * ld + col0;
#pragma unroll
                for (int bj = 0; bj < 2; ++bj) { const f32x4 v0 = acc[ai][bj][m][0] * rr[ai][m], v1 = acc[ai][bj][m][1] * rr[ai][m];
                    u32x4 w; w.x = cvt_pk_bf16(v0[0], v0[1]); w.y = cvt_pk_bf16(v0[2], v0[3]); w.z = cvt_pk_bf16(v1[0], v1[1]); w.w = cvt_pk_bf16(v1[2], v1[3]);
                    *(u32x4*)(rowp + bj * HALF) = w; } }
    }
};
struct EpiGate {
    static constexpr bool PERM = true;
    bf16_t* O; const float* bias; const LAS float* part;
    __device__ __forceinline__ void operator()(AccRef acc, const Unit& u, int wr, int wc, int fr, int fq) const {
        const int row0 = u.pm * BM + wr * 64 + fr, col0 = u.pn * BM + wc * 32 + 8 * fq;
        float rr[2][4]; row_scales(part, wr * 64 + fr, rr);
#pragma unroll
        for (int bj = 0; bj < 2; ++bj) { const f32x4 b0 = *(const f32x4*)(bias + col0 + bj * HALF), b1 = *(const f32x4*)(bias + col0 + bj * HALF + 4);
#pragma unroll
            for (int ai = 0; ai < 2; ++ai)
#pragma unroll
                for (int m = 0; m < 4; ++m) { bf16_t* rowp = O + (size_t)(row0 + ai * HALF + m * 16) * 3072 + col0 + bj * HALF;
                    const f32x4 v0 = acc[ai][bj][m][0] * rr[ai][m] + b0, v1 = acc[ai][bj][m][1] * rr[ai][m] + b1;
                    u32x4 w; w.x = cvt_pk_bf16(sigmoidf_(v0[0]), sigmoidf_(v0[1])); w.y = cvt_pk_bf16(sigmoidf_(v0[2]), sigmoidf_(v0[3]));
                    w.z = cvt_pk_bf16(sigmoidf_(v1[0]), sigmoidf_(v1[1])); w.w = cvt_pk_bf16(sigmoidf_(v1[2]), sigmoidf_(v1[3]));
                    *(u32x4*)rowp = w; } }
    }
};
struct EpiBranchCat {
    static constexpr bool PERM = true;
    const bf16_t* gates; bf16_t* mb;
    typedef f32x4 (&AccMut)[2][2][4][2];
    __device__ __forceinline__ void rescale(AccMut acc, const Unit& u, int which, int wr, int wc, int fr, int fq) const {
        int row0 = u.pm * BM + wr * 64 + fr, col0 = u.pn * BM + wc * 32 + 8 * fq;
        asm volatile("" : "+v"(row0), "+v"(col0));
#pragma unroll
        for (int ai = 0; ai < 2; ++ai) {
            u32x4 gav[4][2], gbv[4][2];
#pragma unroll
            for (int m = 0; m < 4; ++m)
#pragma unroll
                for (int bj = 0; bj < 2; ++bj) { const bf16_t* gp = gates + (size_t)(row0 + ai * HALF + m * 16) * 3072 + which * 1024 + col0 + bj * HALF; gav[m][bj] = *(const u32x4*)gp; gbv[m][bj] = *(const u32x4*)(gp + 1024); }
#pragma unroll
            for (int m = 0; m < 4; ++m)
#pragma unroll
                for (int bj = 0; bj < 2; ++bj) { const u32x4 ga = gav[m][bj], gb = gbv[m][bj];
                    acc[ai][bj][m][0][0] *= lo_bf(ga.x) * __builtin_amdgcn_rcpf(lo_bf(gb.x)); acc[ai][bj][m][0][1] *= hi_bf(ga.x) * __builtin_amdgcn_rcpf(hi_bf(gb.x)); acc[ai][bj][m][0][2] *= lo_bf(ga.y) * __builtin_amdgcn_rcpf(lo_bf(gb.y)); acc[ai][bj][m][0][3] *= hi_bf(ga.y) * __builtin_amdgcn_rcpf(hi_bf(gb.y));
                    acc[ai][bj][m][1][0] *= lo_bf(ga.z) * __builtin_amdgcn_rcpf(lo_bf(gb.z)); acc[ai][bj][m][1][1] *= hi_bf(ga.z) * __builtin_amdgcn_rcpf(hi_bf(gb.z)); acc[ai][bj][m][1][2] *= lo_bf(ga.w) * __builtin_amdgcn_rcpf(lo_bf(gb.w)); acc[ai][bj][m][1][3] *= hi_bf(ga.w) * __builtin_amdgcn_rcpf(hi_bf(gb.w)); }
            __builtin_amdgcn_sched_barrier(0); }
    }
    __device__ __forceinline__ void operator()(AccRef acc, const Unit& u, int wr, int wc, int fr, int fq) const {
        const int row0 = u.pm * BM + wr * 64 + fr, col0 = u.pn * BM + wc * 32 + 8 * fq;
#pragma unroll
        for (int ai = 0; ai < 2; ++ai) {
            u32x4 gwv[4][2];
#pragma unroll
            for (int m = 0; m < 4; ++m)
#pragma unroll
                for (int bj = 0; bj < 2; ++bj) gwv[m][bj] = *(const u32x4*)(gates + (size_t)(row0 + ai * HALF + m * 16) * 3072 + 2048 + col0 + bj * HALF);
#pragma unroll
            for (int m = 0; m < 4; ++m) { const size_t row = (size_t)(row0 + ai * HALF + m * 16);
#pragma unroll
                for (int bj = 0; bj < 2; ++bj) { const int col = col0 + bj * HALF;
                    const u32x4 gw = gwv[m][bj];
                    const f32x4 v0 = acc[ai][bj][m][0], v1 = acc[ai][bj][m][1];
                    u32x4 w; w.x = cvt_pk_bf16(v0[0] * lo_bf(gw.x), v0[1] * hi_bf(gw.x)); w.y = cvt_pk_bf16(v0[2] * lo_bf(gw.y), v0[3] * hi_bf(gw.y));
                    w.z = cvt_pk_bf16(v1[0] * lo_bf(gw.z), v1[1] * hi_bf(gw.z)); w.w = cvt_pk_bf16(v1[2] * lo_bf(gw.w), v1[3] * hi_bf(gw.w));
                    *(u32x4*)(mb + row * DM + col) = w; } } }
    }
};
struct EpiRG {
    static constexpr bool PERM = false;
    const bf16_t* xc; bf16_t* loga; bf16_t* uu;
    const float* ba; const float* bx; const float* lam;
    __device__ __forceinline__ void operator()(AccRef acc, const Unit& u, int wr, int wc, int fr, int fq) const {
        const int row0 = u.pm * BM + wr * 64 + fr;
#pragma unroll
        for (int bj = 0; bj < 2; ++bj) { const int c = u.pn * BM + bj * HALF + wc * 32; const int dir = c >> 10; const int ch = ((c & 1023) >> 1) + 4 * fq;
            const f32x4 vba = *(const f32x4*)(ba + dir * 512 + ch), vbx = *(const f32x4*)(bx + dir * 512 + ch), vl = *(const f32x4*)(lam + dir * 512 + ch);
            const f32x4 cc = vl;
#pragma unroll
            for (int ai = 0; ai < 2; ++ai) {
                u32x2 xwv[4];
#pragma unroll
                for (int m = 0; m < 4; ++m) xwv[m] = *(const u32x2*)(xc + (size_t)(row0 + ai * HALF + m * 16) * 512 + ch);
#pragma unroll
                for (int m = 0; m < 4; ++m) { const size_t row = (size_t)(row0 + ai * HALF + m * 16);
                    const u32x2 xw = xwv[m];
                    const float xv[4] = {lo_bf(xw.x), hi_bf(xw.x), lo_bf(xw.y), hi_bf(xw.y)};
                    float la[4], uo[4];
#pragma unroll
                    for (int i = 0; i < 4; ++i) { const float r = sigmoidf_(acc[ai][bj][m][0][i] + vba[i]), gi = sigmoidf_(acc[ai][bj][m][1][i] + vbx[i]);
                        const float l = cc[i] * r; la[i] = l; const float x2 = 2.0f * l;
                        const float em1 = (x2 > -0.25f) ? x2 * (1.0f + x2 * (0.5f + x2 * (1.0f / 6.0f + x2 * (1.0f / 24.0f + x2 * (1.0f / 120.0f + x2 * (1.0f / 720.0f)))))) : (__expf(x2) - 1.0f);
                        uo[i] = __builtin_amdgcn_sqrtf(fmaxf(-em1, 0.0f)) * gi * xv[i]; }
                    u32x2 w0, w1; w0.x = cvt_pk_bf16(la[0], la[1]); w0.y = cvt_pk_bf16(la[2], la[3]); w1.x = cvt_pk_bf16(uo[0], uo[1]); w1.y = cvt_pk_bf16(uo[2], uo[3]);
                    *(u32x2*)(loga + ((size_t)dir * MT + row) * 512 + ch) = w0; *(u32x2*)(uu + ((size_t)dir * MT + row) * 512 + ch) = w1; } } }
    }
};

struct GDesc { const bf16_t* A; const bf16_t* Bt; int M, N, K, kind; void* p0; void* p1; const void* q0; const void* q1; const void* q2; const void* q3; int i0, i1, i2; float f0; };
struct EpiAny {
    GDesc d;
    __device__ __forceinline__ bool hook() const { return d.kind == 4; }
    __device__ __forceinline__ void rescale(f32x4 (&acc)[2][2][4][2], const Unit& u, int which, int wr, int wc, int fr, int fq) const { EpiBranchCat e; e.gates = (const bf16_t*)d.q0; e.mb = nullptr; e.rescale(acc, u, which, wr, wc, fr, fq); }
    __device__ __forceinline__ void operator()(AccRef acc, const Unit& u, int ui, int wr, int wc, int fr, int fq) const {
        const LAS float* rt = (const LAS float*)((LAS unsigned char*)g_smem + RT_OFF) + ui * 256;
        switch (d.kind) {
        case 0: { EpiSwiGLU e; e.act = (bf16_t*)d.p0; e.part = rt; e(acc, u, wr, wc, fr, fq); } break;
        case 1: { EpiResid e; e.h = (float*)d.p0; e.scale = d.f0; e.hb = (bf16_t*)d.p1; e.part = (float*)d.q3; e(acc, u, wr, wc, fr, fq); } break;
        case 2: { EpiBf16Split e; e.O0 = (bf16_t*)d.p0; e.ld0 = d.i0; e.O1 = (bf16_t*)d.p1; e.ld1 = d.i1; e.split = d.i2; e.part = rt; e(acc, u, wr, wc, fr, fq); } break;
        case 3: { EpiGate e; e.O = (bf16_t*)d.p0; e.bias = (const float*)d.q0; e.part = rt; e(acc, u, wr, wc, fr, fq); } break;
        case 4: { EpiBranchCat e; e.gates = (const bf16_t*)d.q0; e.mb = (bf16_t*)d.p1; e(acc, u, wr, wc, fr, fq); } break;
        default: { EpiRG e; e.xc = (const bf16_t*)d.q0; e.loga = (bf16_t*)d.p0; e.uu = (bf16_t*)d.p1; e.ba = (const float*)d.q1; e.bx = (const float*)d.q2; e.lam = (const float*)d.q3; e(acc, u, wr, wc, fr, fq); } break;
        }
    }
};
__device__ __forceinline__ void run_gemm(unsigned char* smem, const GDesc& d) {
    pg8::Gemm g; g.A = d.A; g.Bt = d.Bt; g.M = d.M; g.N = d.N; g.K = d.K;
    pg8::StaticOrder S; S.init(d.M, d.N, (int)gridDim.x, (int)blockIdx.x);
    EpiAny E; E.d = d;
    if (d.kind == 0 || d.kind == 2 || d.kind == 3) {
        const float* part = (const float*)d.q3; float* rtab = (float*)(smem + RT_OFF); int* pmtab = (int*)(smem + RT_OFF + 12 * 1024); const int tid = TIDX;
        if (tid < 16) { pg8::Unit u; pmtab[tid] = S.next(tid, u) ? u.pm : -1; }
        __syncthreads();
#pragma unroll
        for (int k = 0; k < 6; ++k) { const int idx = tid + 512 * k, i = idx >> 8, row = idx & 255; const int pm = (i < 12) ? pmtab[i] : -1;
            if (pm >= 0) { const f32x4* pp = (const f32x4*)(part + (size_t)(pm * BM + row) * 16); const f32x4 a = pp[0], b = pp[1], c = pp[2], e4 = pp[3];
                const float ss = ((a[0] + a[1]) + (a[2] + a[3])) + ((b[0] + b[1]) + (b[2] + b[3])) + ((c[0] + c[1]) + (c[2] + c[3])) + ((e4[0] + e4[1]) + (e4[2] + e4[3]));
                rtab[idx] = 1.0f / sqrtf(ss * (1.0f / DM) + 1e-6f); } }
        __syncthreads();
    }
    pg8::gemm_phase<EpiAny>((LAS unsigned char*)smem, g, S, E, !(d.kind == 0 || d.kind == 7));
    __syncthreads();
}

template <class F>
__device__ __forceinline__ void conv_tiles(float* tile, bf16_t* Bt, int R, int K, int rot, F src, int ld = 0) {
    if (ld == 0) ld = K;
    const int tid = TIDX, lane = tid & 63, w = tid >> 6;
    const int nkt = K / 64, ntile = (R / 64) * nkt;
    const int first = ((int)blockIdx.x + rot) % (int)gridDim.x;
    for (int t_ = first; t_ < ntile * ((REP & 1) + 1); t_ += gridDim.x) { const int t = t_ % ntile;
        const int r0 = (t / nkt) * 64, k0 = (t % nkt) * 64;
        __syncthreads();
#pragma unroll
        for (int i = 0; i < 8; ++i) { const int kk = i * 8 + w; tile[kk * 65 + lane] = src(k0 + kk, r0 + lane); }
        __syncthreads();
#pragma unroll
        for (int i = 0; i < 8; ++i) { const int j = i * 8 + w; Bt[(size_t)(r0 + j) * ld + k0 + lane] = f2bf(tile[lane * 65 + j]); }
    }
}

__device__ void convert_phase(unsigned char* smem, const Params& p, int l) {
    float* tile = (float*)smem; bf16_t* wt = (bf16_t*)(((unsigned char*)ldp(38)) + OFF_WT);
    const size_t uo = (size_t)l * DM * DFF;
    { const float* wg = ((const float*)ldp(2)) + uo; const float* wu = ((const float*)ldp(3)) + uo; const float* gn = ((const float*)ldp(1)) + l * DM;
      conv_tiles(tile, wt + W_UP1, 5632, 1024, 0, [=](int k, int r) { const int col = (r >> 5) * 16 + (r & 15); return gn[k] * (((r >> 4) & 1) ? __builtin_nontemporal_load(&wu[(size_t)k * DFF + col]) : __builtin_nontemporal_load(&wg[(size_t)k * DFF + col])); }); }
    { const float* wd = ((const float*)ldp(4)) + uo; conv_tiles(tile, wt + W_DN1, 1024, 2816, 37, [=](int k, int r) { return __builtin_nontemporal_load(&wd[(size_t)k * DM + r]); }); }
    { const float* wi = ((const float*)ldp(6)) + (size_t)l * DM * INC; const float* gn = ((const float*)ldp(5)) + l * DM;
      conv_tiles(tile, wt + W_HYRG, 2560, 1024, 71, [=](int k, int r) { const int col = r < HYC ? r : r + QKVC; return gn[k] * __builtin_nontemporal_load(&wi[(size_t)k * INC + col]); });
      conv_tiles(tile, wt + W_QKV, 4608, 1024, 113, [=](int k, int r) { return gn[k] * __builtin_nontemporal_load(&wi[(size_t)k * INC + HYC + r]); }); }
    { const float* wgt = ((const float*)ldp(26)) + (size_t)l * DM * 3072; const float* gn = ((const float*)ldp(5)) + l * DM; conv_tiles(tile, wt + W_GATE, 3072, 1024, 151, [=](int k, int r) { return gn[k] * __builtin_nontemporal_load(&wgt[(size_t)k * 3072 + r]); }); }
    { const float* a = ((const float*)ldp(28)) + (size_t)l * 512 * DM; conv_tiles(tile, wt + W_PCAT + 0, 1024, 512, 193, [=](int k, int r) { return __builtin_nontemporal_load(&a[(size_t)k * DM + r]); }, 1536); }
    { const float* a = ((const float*)ldp(29)) + (size_t)l * 512 * DM; conv_tiles(tile, wt + W_PCAT + 512, 1024, 512, 211, [=](int k, int r) { return __builtin_nontemporal_load(&a[(size_t)k * DM + r]); }, 1536); }
    { const float* a = ((const float*)ldp(30)) + (size_t)l * 512 * DM; conv_tiles(tile, wt + W_PCAT + 1024, 1024, 512, 229, [=](int k, int r) { return __builtin_nontemporal_load(&a[(size_t)k * DM + r]); }, 1536); }
    { const float* a = ((const float*)ldp(31)) + (size_t)l * DM * DM; conv_tiles(tile, wt + W_OUT, 1024, 1024, 17, [=](int k, int r) { return __builtin_nontemporal_load(&a[(size_t)k * DM + r]); }); }
    { const float* wg = ((const float*)ldp(33)) + uo; const float* wu = ((const float*)ldp(34)) + uo; const float* gn = ((const float*)ldp(32)) + l * DM;
      conv_tiles(tile, wt + W_UP2, 5632, 1024, 53, [=](int k, int r) { const int col = (r >> 5) * 16 + (r & 15); return gn[k] * (((r >> 4) & 1) ? __builtin_nontemporal_load(&wu[(size_t)k * DFF + col]) : __builtin_nontemporal_load(&wg[(size_t)k * DFF + col])); }); }
    { const float* wd = ((const float*)ldp(35)) + uo; conv_tiles(tile, wt + W_DN2, 1024, 2816, 97, [=](int k, int r) { return __builtin_nontemporal_load(&wd[(size_t)k * DM + r]); }); }
    { const float* wa = ((const float*)ldp(21)) + (size_t)l * 2 * 8 * 64 * 64; const float* wx = ((const float*)ldp(23)) + (size_t)l * 2 * 8 * 64 * 64;
      conv_tiles(tile, wt + W_RG, 2048, 512, 131, [=](int k, int r) { const int dir = r >> 10, cp = r & 1023, ch = (cp >> 5) * 16 + (cp & 15), hb = ch >> 6, jj = ch & 63;
          if ((k >> 6) != hb) return 0.0f; const float* src = ((cp >> 4) & 1) ? wx : wa; return src[(((size_t)dir * 8 + hb) * 64 + (k & 63)) * 64 + jj]; }); }
    float* sm = (float*)(((unsigned char*)ldp(38)) + OFF_SM);
    if (blockIdx.x == 0) { for (int i = TIDX; i < 1024; i += 512) sm[i] = 0.0f; }
    if (blockIdx.x == 2 % gridDim.x) { const float* lam = ((const float*)ldp(25)) + l * 1024; for (int i = TIDX; i < 1024; i += 512) sm[4224 + i] = -8.0f * log1pf(expf(-lam[i])); }
    if (blockIdx.x == 1 % gridDim.x) {
        const float* rb = ((const float*)ldp(18));
        for (int i = TIDX; i < 24 * 129; i += 512) { const int hh = i / 129, delta = i % 129 - 64, d = 1 << (2 * (hh >> 3)); const int rel = delta * d;
            const int n = rel < 0 ? -rel : rel; int bucket = rel > 0 ? 16 : 0;
            if (n < 8) bucket += n; else { const float nf = (float)n; int lg = 8 + (int)(logf(nf / 8.0f) / 4.852030263919617f * 8.0f); if (lg > 15) lg = 15; bucket += lg; }
            sm[1024 + i] = rb[bucket * 24 + hh]; }
    }
}

__device__ void rmsnorm_phase(const float* src, const float* g, float* copy_dst, bf16_t* xn, float* outf) {
    const int lane = TIDX & 63, gw = blockIdx.x * 8 + (TIDX >> 6), nw = gridDim.x * 8;
    f32x4 gv[4];
#pragma unroll
    for (int j = 0; j < 4; ++j) gv[j] = ((const f32x4*)g)[lane + 64 * j];
    for (int row = gw; row < MT; row += nw) {
        const f32x4* pr = (const f32x4*)(src + (size_t)row * DM); f32x4 v[4]; float ss = 0.f;
#pragma unroll
        for (int j = 0; j < 4; ++j) { v[j] = pr[lane + 64 * j]; ss += v[j][0] * v[j][0] + v[j][1] * v[j][1] + v[j][2] * v[j][2] + v[j][3] * v[j][3]; }
#pragma unroll
        for (int o = 32; o >= 1; o >>= 1) ss += __shfl_xor(ss, o);
        const float r = 1.0f / sqrtf(ss * (1.0f / DM) + 1e-6f);
#pragma unroll
        for (int j = 0; j < 4; ++j) { const f32x4 y = v[j] * r * gv[j];
            if (copy_dst) ((f32x4*)(copy_dst + (size_t)row * DM))[lane + 64 * j] = v[j];
            if (xn) { u32x2 w; w.x = cvt_pk_bf16(y[0], y[1]); w.y = cvt_pk_bf16(y[2], y[3]); ((u32x2*)(xn + (size_t)row * DM))[lane + 64 * j] = w; }
            if (outf) ((f32x4*)(outf + (size_t)row * DM))[lane + 64 * j] = y; }
    }
}

__device__ void prep_phase(const float* x, float* h, bf16_t* hb, float* part) {
    const int tid = TIDX, lane = tid & 63, gw = blockIdx.x * 8 + (tid >> 6), nw = gridDim.x * 8;
    for (int row = gw; row < MT; row += nw) {
        const f32x4* pr = (const f32x4*)(x + (size_t)row * DM); float ss = 0.f;
#pragma unroll
        for (int j = 0; j < 4; ++j) { const f32x4 v = pr[lane + 64 * j]; ss += v[0] * v[0] + v[1] * v[1] + v[2] * v[2] + v[3] * v[3];
            ((f32x4*)(h + (size_t)row * DM))[lane + 64 * j] = v;
            u32x2 w; w.x = cvt_pk_bf16(v[0], v[1]); w.y = cvt_pk_bf16(v[2], v[3]); ((u32x2*)(hb + (size_t)row * DM))[lane + 64 * j] = w; }
#pragma unroll
        for (int o = 32; o >= 1; o >>= 1) ss += __shfl_xor(ss, o);
        if (lane < 16) part[(size_t)row * 16 + lane] = (lane == 0) ? ss : 0.f;
    }
}

__device__ void filter_mlp_phase(unsigned char* smem, int l) {
    float* zz = (float*)smem;
    float* ha = zz + 8 * 36;
    float* hb = ha + 8 * 64;
    const float* w1 = ((const float*)ldp(9)) + (size_t)l * 33 * 64; const float* b1 = ((const float*)ldp(10)) + l * 64; const float* w2 = ((const float*)ldp(11)) + (size_t)l * 64 * 64; const float* b2 = ((const float*)ldp(12)) + l * 64;
    const float* w3 = ((const float*)ldp(13)) + (size_t)l * 64 * 64; const float* b3 = ((const float*)ldp(14)) + l * 64; const float* fr = ((const float*)ldp(15)) + l * 64;
    float* hdn = (float*)(((unsigned char*)ldp(38)) + OFF_HDN);
    const int tid = TIDX, u = tid & 63, ps = tid >> 6;
    for (int tile = blockIdx.x; tile < 256; tile += gridDim.x) {
        const int pos = tile * 8 + ps;
        __syncthreads();
        if (u < 33) { float f;
            if (u == 0) f = (float)pos / 2047.0f;
            else { const int bi = (u - 1) & 15; const float fb = 1e-4f + (float)bi * ((15.0f - 1e-4f) / 15.0f); const float wpos = 6.283185307179586f * (float)pos / 2048.0f; const float arg = fb * wpos;
                f = (u <= 16) ? sin_acc(arg, 1.5707963267948966) : -sin_acc(arg, 0.0); }
            zz[ps * 36 + u] = f; }
        __syncthreads();
        { float a = b1[u];
#pragma unroll 3
            for (int k = 0; k < 33; ++k) a += zz[ps * 36 + k] * w1[k * 64 + u]; ha[ps * 64 + u] = sin_acc(fr[u] * a, 0.0); }
        __syncthreads();
        { float a = b2[u];
#pragma unroll 4
            for (int k = 0; k < 64; ++k) a += ha[ps * 64 + k] * w2[k * 64 + u]; hb[ps * 64 + u] = sin_acc(fr[u] * a, 0.0); }
        __syncthreads();
        { float a = b3[u];
#pragma unroll 4
            for (int k = 0; k < 64; ++k) a += hb[ps * 64 + k] * w3[k * 64 + u]; hdn[pos * 64 + u] = sin_acc(fr[u] * a, 0.0); }
    }
}

__device__ void filter_phase(unsigned char* smem, const Params& p, int l) {
    float* h3 = (float*)smem;
    const float* wout = ((const float*)ldp(16)) + (size_t)l * 64 * 2048; const float* hdn = (const float*)(((unsigned char*)ldp(38)) + OFF_HDN);
    float* hraw = (float*)(((unsigned char*)ldp(38)) + OFF_A + 160 * MiB); float* norms = (float*)(((unsigned char*)ldp(38)) + OFF_SM);
    const int tid = TIDX;
    for (int tile = blockIdx.x; tile < 256; tile += gridDim.x) {
        const int cb = tile & 3, pb = tile >> 2;
        __syncthreads();
        ((f32x4*)h3)[tid] = ((const f32x4*)(hdn + (size_t)pb * 32 * 64))[tid];
        __syncthreads();
        const int c = tid, dir = cb >> 1, o = cb & 1;
        const float da = -4.605170185988091f / 0.3f, db = -4.605170185988091f / 1.5f; const float delta = fabsf(da + (float)c * ((db - da) / 511.0f));
        float asum = 0.f; float* dst = hraw + ((size_t)(dir * 2 + o) * 512 + c) * 2048 + pb * 32;
#pragma unroll 1
        for (int half = 0; half < 2; ++half) {
            float accv[16];
#pragma unroll
            for (int i = 0; i < 16; ++i) accv[i] = 0.f;
#pragma unroll 2
            for (int k = 0; k < 64; ++k) { const float wv = wout[(size_t)k * 2048 + cb * 512 + c];
#pragma unroll
                for (int i = 0; i < 16; ++i) accv[i] += h3[(half * 16 + i) * 64 + k] * wv; }
#pragma unroll
            for (int i = 0; i < 16; ++i) { const int pos = pb * 32 + half * 16 + i; const float t = (float)pos / 2047.0f; const float val = accv[i] * (expf(-t * delta) + 0.05f);
                dst[half * 16 + i] = val; if (!(dir == 1 && pos == 0)) asum += fabsf(val); }
        }
        norms[16384 + pb * 2048 + cb * 512 + c] = asum;
    }
}

__device__ void hy_transpose_phase(unsigned char* smem, const Params& p, int l) {
    float* tile = (float*)smem;
    const bf16_t* uhy = (const bf16_t*)(((unsigned char*)ldp(38)) + OFF_A); bf16_t* hyT = (bf16_t*)(((unsigned char*)ldp(38)) + OFF_B);
    const float* cw = ((const float*)ldp(7)) + (size_t)l * 3 * HYC; const float* cb = ((const float*)ldp(8)) + (size_t)l * HYC;
    const int tid = TIDX;
    const int ntile = (MT / 64) * (HYC / 64);
    for (int t = blockIdx.x; t < ntile; t += gridDim.x) {
        const int cblk = t % (HYC / 64), rblk = t / (HYC / 64); const int b = rblk >> 5, t0 = (rblk & 31) * 64, c0 = cblk * 64;
        __syncthreads();
        for (int e = tid; e < 66 * 8; e += 512) { const int rr = e >> 3, c8 = e & 7; const int tt = t0 - 1 + rr;
            u32x4 v = zero4();
            if (tt >= 0 && tt < SEQ) v = *(const u32x4*)(uhy + ((size_t)b * SEQ + tt) * HYC + c0 + c8 * 8);
            float* d = tile + rr * 65 + c8 * 8;
            d[0] = lo_bf(v.x); d[1] = hi_bf(v.x); d[2] = lo_bf(v.y); d[3] = hi_bf(v.y); d[4] = lo_bf(v.z); d[5] = hi_bf(v.z); d[6] = lo_bf(v.w); d[7] = hi_bf(v.w); }
        __syncthreads();
        { const int cc = tid >> 3, t8 = tid & 7, c = c0 + cc; const float w0 = cw[c], w1 = cw[HYC + c], w2 = cw[2 * HYC + c], bb = cb[c];
          float x[10];
#pragma unroll
          for (int i = 0; i < 10; ++i) x[i] = tile[(t8 * 8 + i) * 65 + cc];
          float o[8];
#pragma unroll
          for (int i = 0; i < 8; ++i) o[i] = w0 * x[i] + w1 * x[i + 1] + w2 * x[i + 2] + bb;
          u32x4 w; w.x = cvt_pk_bf16(o[0], o[1]); w.y = cvt_pk_bf16(o[2], o[3]); w.z = cvt_pk_bf16(o[4], o[5]); w.w = cvt_pk_bf16(o[6], o[7]);
          *(u32x4*)(hyT + ((size_t)c * NB + b) * SEQ + t0 + t8 * 8) = w; }
    }
}

__device__ void ya_transpose_phase(unsigned char* smem) {
    bf16_t* tile = (bf16_t*)smem;
    const bf16_t* yaT = (const bf16_t*)(((unsigned char*)ldp(38)) + OFF_A); bf16_t* ya = (bf16_t*)(((unsigned char*)ldp(38)) + OFF_YA);
    const int tid = TIDX;
    const int ntile = (MT / 64) * (HYW / 64);
    for (int t = blockIdx.x; t < ntile; t += gridDim.x) {
        const int cblk = t % (HYW / 64), rblk = t / (HYW / 64); const int b = rblk >> 5, t0 = (rblk & 31) * 64, c0 = cblk * 64;
        __syncthreads();
        { const int cc = tid >> 3, t8 = tid & 7; *(u32x4*)(tile + cc * 72 + t8 * 8) = *(const u32x4*)(yaT + ((size_t)(c0 + cc) * NB + b) * SEQ + t0 + t8 * 8); }
        __syncthreads();
        { const int tt = tid >> 3, c8 = tid & 7; unsigned short v[8];
#pragma unroll
          for (int i = 0; i < 8; ++i) v[i] = tile[(c8 * 8 + i) * 72 + tt];
          u32x4 w; w.x = (unsigned)v[0] | ((unsigned)v[1] << 16); w.y = (unsigned)v[2] | ((unsigned)v[3] << 16); w.z = (unsigned)v[4] | ((unsigned)v[5] << 16); w.w = (unsigned)v[6] | ((unsigned)v[7] << 16);
          *(u32x4*)(ya + ((size_t)b * SEQ + t0 + tt) * 1536 + c0 + c8 * 8) = w; }
    }
}

__device__ void rg_conv_phase(const Params& p, int l) {
    const bf16_t* urg = (const bf16_t*)(((unsigned char*)ldp(38)) + OFF_A + 96 * MiB); bf16_t* xc = (bf16_t*)(((unsigned char*)ldp(38)) + OFF_XC);
    const float* cw = ((const float*)ldp(19)) + (size_t)l * 4 * RGW; const float* cb = ((const float*)ldp(20)) + (size_t)l * RGW;
    const int total = (MT / 16) * 64;
    for (int idx = blockIdx.x * 512 + TIDX; idx < total; idx += gridDim.x * 512) {
        const int c8 = idx & 63, run = idx >> 6, tok0 = run * 16, t0 = tok0 & (SEQ - 1);
        float wgt[4][8], bia[8];
#pragma unroll
        for (int i = 0; i < 8; ++i) { bia[i] = cb[c8 * 8 + i];
#pragma unroll
            for (int k = 0; k < 4; ++k) wgt[k][i] = cw[k * RGW + c8 * 8 + i]; }
        u32x4 win[4];
        const bf16_t* src = urg + (size_t)tok0 * 1024 + c8 * 8;
#pragma unroll
        for (int k = 0; k < 3; ++k) { const int tt = t0 + k - 2; win[k + 1] = (tt >= 0 && tt < SEQ) ? *(const u32x4*)(src + (ptrdiff_t)(k - 2) * 1024) : zero4(); }
#pragma unroll
        for (int i = 0; i < 16; ++i) {
            win[0] = win[1]; win[1] = win[2]; win[2] = win[3];
            { const int tt = t0 + i + 1; win[3] = (tt < SEQ) ? *(const u32x4*)(src + (ptrdiff_t)(i + 1) * 1024) : zero4(); }
            float a[8];
#pragma unroll
            for (int e = 0; e < 8; ++e) a[e] = bia[e];
#pragma unroll
            for (int k = 0; k < 4; ++k) { const u32x4 xv = win[k];
                a[0] += wgt[k][0] * lo_bf(xv.x); a[1] += wgt[k][1] * hi_bf(xv.x); a[2] += wgt[k][2] * lo_bf(xv.y); a[3] += wgt[k][3] * hi_bf(xv.y);
                a[4] += wgt[k][4] * lo_bf(xv.z); a[5] += wgt[k][5] * hi_bf(xv.z); a[6] += wgt[k][6] * lo_bf(xv.w); a[7] += wgt[k][7] * hi_bf(xv.w); }
            u32x4 w; w.x = cvt_pk_bf16(a[0], a[1]); w.y = cvt_pk_bf16(a[2], a[3]); w.z = cvt_pk_bf16(a[4], a[5]); w.w = cvt_pk_bf16(a[6], a[7]);
            *(u32x4*)(xc + (size_t)(tok0 + i) * 512 + c8 * 8) = w;
        }
    }
}

__device__ void filter_finalize_phase() {
    unsigned char* ws = (unsigned char*)ldp(38);
    const float* hraw = (const float*)(ws + OFF_A + 160 * MiB); const float* norms = (const float*)(ws + OFF_SM); bf16_t* rv = (bf16_t*)(ws + OFF_YA);
    const int tid = TIDX, lane = tid & 63, gw = blockIdx.x * 8 + (tid >> 6), nw = gridDim.x * 8;
    for (int oc = gw; oc < 1024; oc += nw) {
        const int o = oc >> 9, c = oc & 511;
        float ns = norms[16384 + lane * 2048 + o * 512 + c] + norms[16384 + lane * 2048 + (2 + o) * 512 + c];
#pragma unroll
        for (int sft = 32; sft >= 1; sft >>= 1) ns += __shfl_xor(ns, sft);
        const float scale = 1.0f / (ns + 1e-6f);
        const float* kf = hraw + ((size_t)(0 * 2 + o) * 512 + c) * 2048; const float* kb = hraw + ((size_t)(1 * 2 + o) * 512 + c) * 2048;
        for (int it = 0; it < 8; ++it) { const int i0 = it * 512 + lane * 8; float v[8];
#pragma unroll
            for (int e = 0; e < 8; ++e) { const int d = 2048 - (i0 + e); float x = 0.f; if (d >= 0 && d <= 2047) x = kf[d]; else if (d < 0 && d >= -2047) x = kb[-d]; v[e] = x * scale; }
            u32x4 w; w.x = cvt_pk_bf16(v[0], v[1]); w.y = cvt_pk_bf16(v[2], v[3]); w.z = cvt_pk_bf16(v[4], v[5]); w.w = cvt_pk_bf16(v[6], v[7]);
            *(u32x4*)(rv + (size_t)oc * 4096 + i0) = w; }
    }
}

constexpr int ZS = 2056;
constexpr int FS = 4104;
__device__ void hyena_phase(unsigned char* smem, const Params& p, int l, int order) {
    bf16_t* zs = (bf16_t*)smem;
    bf16_t* fs = (bf16_t*)(smem + 16 * ZS * 2);
    unsigned char* ws = (unsigned char*)ldp(38);
    const bf16_t* hyT = (const bf16_t*)(ws + OFF_B); bf16_t* z1T = (bf16_t*)(ws + OFF_B + 96 * MiB); bf16_t* yaT = (bf16_t*)(ws + OFF_A);
    const bf16_t* rvp = (const bf16_t*)(ws + OFF_YA);
    const float* skip = ((const float*)ldp(17)) + (size_t)l * 2 * HYW + order * HYW;
    const int tid = TIDX, lane = tid & 63, w = tid >> 6, r16 = lane & 15, g4 = lane >> 4;
    for (int c = blockIdx.x; c < HYW; c += gridDim.x) {
        const bf16_t* zin = (order == 0) ? hyT + (size_t)c * NB * SEQ : z1T + (size_t)c * NB * SEQ;
        const bf16_t* gin = hyT + ((size_t)(order + 1) * HYW + c) * NB * SEQ;
        bf16_t* dst = (order == 0 ? z1T : yaT) + (size_t)c * NB * SEQ;
        const float sk = skip[c];
        __syncthreads();
        { const u32x4 rw = *(const u32x4*)(rvp + ((size_t)order * 512 + c) * 4096 + tid * 8);
          const unsigned short e[8] = {(unsigned short)(rw.x & 0xffff), (unsigned short)(rw.x >> 16), (unsigned short)(rw.y & 0xffff), (unsigned short)(rw.y >> 16),
                                       (unsigned short)(rw.z & 0xffff), (unsigned short)(rw.z >> 16), (unsigned short)(rw.w & 0xffff), (unsigned short)(rw.w >> 16)};
#pragma unroll
          for (int m = 0; m < 8; ++m) {
#pragma unroll
              for (int k = 0; k < 8; ++k) { const int x = tid * 8 + k - m; if (x >= 0) fs[m * FS + x] = e[k]; } } }
        for (int idx = tid; idx < 16 * 256; idx += 512) { const int b = idx >> 8, s8 = idx & 255; *(u32x4*)(zs + b * ZS + s8 * 8) = *(const u32x4*)(zin + (size_t)b * SEQ + s8 * 8); }
        __syncthreads();
        const int mcopy = (8 - (r16 & 7)) & 7;
        const bf16_t* fbase = fs + mcopy * FS - mcopy + 2048 - r16 + 8 * g4;
        const bf16_t* zbase = zs + r16 * ZS + 8 * g4;
        for (int mg = 0; mg < 2; ++mg) {
            const int tb = w * 256 + mg * 128;
            f32x4 acc[8];
#pragma unroll
            for (int mi = 0; mi < 8; ++mi) acc[mi] = (f32x4){0.f, 0.f, 0.f, 0.f};
            const bf16_t* fg = fbase - tb;
            bf16x8 W[8];
#pragma unroll
            for (int i = 0; i < 8; ++i) W[i] = *(const bf16x8*)(fg - 16 * i);
#pragma unroll 4
            for (int ks = 0; ks < 64; ++ks) {
                const bf16x8 bfr = *(const bf16x8*)(zbase + ks * 32);
                bf16x8 n0 = W[0], n1 = W[0];
                if (ks < 63) { n0 = *(const bf16x8*)(fg + 16 * (2 * ks + 2)); n1 = *(const bf16x8*)(fg + 16 * (2 * ks + 1)); }
#pragma unroll
                for (int mi = 0; mi < 8; ++mi) acc[mi] = __builtin_amdgcn_mfma_f32_16x16x32_bf16(W[mi], bfr, acc[mi], 0, 0, 0);
#pragma unroll
                for (int i = 7; i >= 2; --i) W[i] = W[i - 2];
                W[0] = n0; W[1] = n1;
            }
#pragma unroll
            for (int mi = 0; mi < 8; ++mi) { const int t = tb + mi * 16 + 4 * g4;
                const u32x2 gw = *(const u32x2*)(gin + (size_t)r16 * SEQ + t); const u32x2 zw = *(const u32x2*)(zs + r16 * ZS + t);
                const float gv[4] = {lo_bf(gw.x), hi_bf(gw.x), lo_bf(gw.y), hi_bf(gw.y)}; const float zv[4] = {lo_bf(zw.x), hi_bf(zw.x), lo_bf(zw.y), hi_bf(zw.y)};
                float o[4];
#pragma unroll
                for (int i = 0; i < 4; ++i) o[i] = gv[i] * (acc[mi][i] + sk * zv[i]);
                u32x2 wv; wv.x = cvt_pk_bf16(o[0], o[1]); wv.y = cvt_pk_bf16(o[2], o[3]); *(u32x2*)(dst + (size_t)r16 * SEQ + t) = wv; }
        }
    }
}

__device__ void rg_scan_phase(unsigned char* smem, const Params& p) {
    float* carr = (float*)smem;
    unsigned char* ws = (unsigned char*)ldp(38);
    const bf16_t* loga = (const bf16_t*)(ws + OFF_B); const bf16_t* uu = (const bf16_t*)(ws + OFF_B + 64 * MiB);
    const bf16_t* urg = (const bf16_t*)(ws + OFF_A + 96 * MiB); bf16_t* yc = (bf16_t*)(ws + OFF_YA); bf16_t* hfb = (bf16_t*)(ws + OFF_XC);
    const int tid = TIDX, ch = tid & 31, seg = tid >> 5;
    for (int tile = blockIdx.x; tile < NB * 16; tile += gridDim.x) {
        const int b = tile >> 4, j = (tile & 15) * 32 + ch;
        const size_t base = ((size_t)b * SEQ + seg * 128) * 512 + j;
        const bf16_t* la0 = loga + base; const bf16_t* u0 = uu + base; const bf16_t* la1 = loga + (size_t)MT * 512 + base; const bf16_t* u1 = uu + (size_t)MT * 512 + base;
        float A0 = 1.f, H0 = 0.f, A1 = 1.f, H1 = 0.f;
#pragma unroll 16
        for (int i = 0; i < 128; ++i) { const int tb = 127 - i;
            const float a0 = __expf(bf2f(la0[(size_t)i * 512])); H0 = a0 * H0 + bf2f(u0[(size_t)i * 512]); A0 *= a0;
            const float a1 = __expf(bf2f(la1[(size_t)tb * 512])); H1 = a1 * H1 + bf2f(u1[(size_t)tb * 512]); A1 *= a1; }
        __syncthreads();
        carr[((0 * 16 + seg) * 32 + ch) * 2] = A0; carr[((0 * 16 + seg) * 32 + ch) * 2 + 1] = H0;
        carr[((1 * 16 + seg) * 32 + ch) * 2] = A1; carr[((1 * 16 + seg) * 32 + ch) * 2 + 1] = H1;
        __syncthreads();
        float hf = 0.f, hb = 0.f;
        for (int s = 0; s < seg; ++s) hf = carr[((0 * 16 + s) * 32 + ch) * 2] * hf + carr[((0 * 16 + s) * 32 + ch) * 2 + 1];
        for (int s = 15; s > seg; --s) hb = carr[((1 * 16 + s) * 32 + ch) * 2] * hb + carr[((1 * 16 + s) * 32 + ch) * 2 + 1];
        bf16_t* hfp = hfb + base;
#pragma unroll 16
        for (int i = 0; i < 128; ++i) { const float a = __expf(bf2f(la0[(size_t)i * 512])); hf = a * hf + bf2f(u0[(size_t)i * 512]); hfp[(size_t)i * 512] = f2bf(hf); }
        const bf16_t* gp = urg + ((size_t)b * SEQ + seg * 128) * 1024 + 512 + j; bf16_t* yo = yc + ((size_t)b * SEQ + seg * 128) * 1536 + 1024 + j;
#pragma unroll 16
        for (int i = 0; i < 128; ++i) { const int tt = 127 - i; const float a = __expf(bf2f(la1[(size_t)tt * 512])); hb = a * hb + bf2f(u1[(size_t)tt * 512]);
            const float gx = bf2f(gp[(size_t)tt * 1024]); const float inner = 0.7978845608028654f * (gx + 0.044715f * gx * gx * gx);
            const float th = 1.0f - 2.0f * __builtin_amdgcn_rcpf(1.0f + __expf(2.0f * inner)); const float ge = 0.5f * gx * (1.0f + th);
            yo[(size_t)tt * 1536] = f2bf((bf2f(hfp[(size_t)tt * 512]) + hb) * ge); }
    }
}

constexpr int KST = 72, VSR = 72, AKR = 272;
typedef short s16x4 __attribute__((ext_vector_type(4)));
__device__ void attn_phase(unsigned char* smem, const Params& p, int chunk) {
    bf16_t* qkv = (bf16_t*)(((unsigned char*)ldp(38)) + OFF_A); float* lse = (float*)(((unsigned char*)ldp(38)) + OFF_XC);
    const float* biastab = (const float*)(((unsigned char*)ldp(38)) + OFF_SM) + 1024;
    const int tid = TIDX, lane = tid & 63, w = tid >> 6, half = w >> 2, qs = w & 3, r16 = lane & 15, g4 = lane >> 4;
    bf16_t* Ks = (bf16_t*)smem; bf16_t* Vs = (bf16_t*)(smem + AKR * KST * 2); float* bs = (float*)(smem + AKR * KST * 2 + AKR * VSR * 2);
    const int npair = NB * 24 * 32 / 2;
    u32x4 kreg[5], vreg[5]; bf16x8 qn[2]; float bn = 0.f;
#define ATT_DECODE(pr) const int tile0 = (pr) * 2; const int qb0 = tile0 & 31, hh = (tile0 >> 5) % 24, b = tile0 / (32 * 24); \
        const int grp = hh >> 3, dsh = 2 * grp, nbk = 32 >> dsh, Ls = SEQ >> dsh; const int res = qb0 / nbk, n0 = qb0 % nbk, n = n0 + half; const size_t brow = (size_t)b * SEQ;
#define ATT_PREFETCH(pr) do { ATT_DECODE(pr) \
        _Pragma("unroll") for (int it = 0; it < 5; ++it) { const int chunkid = tid + 512 * it; const int key = chunkid >> 3, part = chunkid & 7; const int kp = n0 * 64 + key - 64; \
            kreg[it] = zero4(); vreg[it] = kreg[it]; \
            if (chunkid < AKR * 8 && key < 256 && kp >= 0 && kp < Ls) { const size_t tok = brow + ((size_t)kp << dsh) + res; const bf16_t* src = qkv + tok * QKVC + hh * 64 + part * 8; kreg[it] = *(const u32x4*)(src + 1536); vreg[it] = *(const u32x4*)(src + 3072); } } \
        { const int qp = n * 64 + qs * 16 + r16; const size_t qtok = brow + ((size_t)qp << dsh) + res; \
          _Pragma("unroll") for (int ks = 0; ks < 2; ++ks) qn[ks] = *(const bf16x8*)(qkv + qtok * QKVC + hh * 64 + ks * 32 + g4 * 8); } \
        bn = (tid < 129) ? biastab[hh * 129 + tid] * 1.4426950408889634f : 0.f; } while (0)
    const int nrep = ((REP >> 5) & 1) + 1;
    int pair_ = blockIdx.x;
    if (pair_ < npair * nrep) ATT_PREFETCH(pair_ % npair);
    for (; pair_ < npair * nrep; pair_ += gridDim.x) { const int pair = pair_ % npair;
        ATT_DECODE(pair)
        __syncthreads();
#pragma unroll
        for (int it = 0; it < 5; ++it) { const int chunkid = tid + 512 * it; if (chunkid < AKR * 8) { const int key = chunkid >> 3, part = chunkid & 7;
            *(u32x4*)(Ks + key * KST + part * 8) = kreg[it]; *(u32x4*)(Vs + key * VSR + part * 8) = vreg[it]; } }
        if (tid < 129) bs[tid] = bn;
        bf16x8 qf[2]; qf[0] = qn[0]; qf[1] = qn[1];
        __syncthreads();
        if (pair_ + (int)gridDim.x < npair * nrep) ATT_PREFETCH((pair_ + (int)gridDim.x) % npair);
        const int hoff = 64 * half;
        const int qi = qs * 16 + r16; const int qp = n * 64 + qi; const size_t qtok = brow + ((size_t)qp << dsh) + res;
        int lo = -64, hi = 64;
        if (n == 0) lo = max(-64, -qi);
        if (n == nbk - 1) hi = min(64, 63 - qi);
        const int cbase = 4 * g4 - r16 - 64;
        const unsigned ub = (unsigned)(cbase - lo), rng = (unsigned)(hi - lo);
        const float* bl = bs + (cbase + 64);
        f32x4 s[10];
#pragma unroll
        for (int kt = 0; kt < 9; ++kt) { s[kt] = (f32x4){0.f, 0.f, 0.f, 0.f};
#pragma unroll
            for (int ks = 0; ks < 2; ++ks) { const bf16x8 kfr = *(const bf16x8*)(Ks + (hoff + qs * 16 + kt * 16 + r16) * KST + ks * 32 + g4 * 8); s[kt] = __builtin_amdgcn_mfma_f32_16x16x32_bf16(kfr, qf[ks], s[kt], 0, 0, 0); } }
        s[9] = (f32x4){0.f, 0.f, 0.f, 0.f};
        float mx = -1e30f;
#pragma unroll
        for (int kt = 0; kt < 9; ++kt)
#pragma unroll
            for (int i = 0; i < 4; ++i) { const bool valid = (ub + (unsigned)(16 * kt + i)) <= rng;
                const float v = valid ? __builtin_fmaf(s[kt][i], 0.125f * 1.4426950408889634f, bl[16 * kt + i]) : -1e30f; s[kt][i] = v; mx = fmaxf(mx, v); }
        mx = fmaxf(mx, __shfl_xor(mx, 16)); mx = fmaxf(mx, __shfl_xor(mx, 32));
        float den = 0.f;
#pragma unroll
        for (int kt = 0; kt < 9; ++kt)
#pragma unroll
            for (int i = 0; i < 4; ++i) { const float e = __builtin_amdgcn_exp2f(s[kt][i] - mx); s[kt][i] = e; den += e; }
        den += __shfl_xor(den, 16); den += __shfl_xor(den, 32);
        f32x4 o[4];
#pragma unroll
        for (int et = 0; et < 4; ++et) o[et] = (f32x4){0.f, 0.f, 0.f, 0.f};
        const bf16_t* vbase = Vs + (hoff + qs * 16 + 4 * g4 + (r16 >> 2)) * VSR + 4 * (r16 & 3);
#pragma unroll
        for (int cc = 0; cc < 5; ++cc) {
            union { u32x4 u; bf16x8 v; } pf; pf.u.x = cvt_pk_bf16(s[2 * cc][0], s[2 * cc][1]); pf.u.y = cvt_pk_bf16(s[2 * cc][2], s[2 * cc][3]);
            pf.u.z = cvt_pk_bf16(s[2 * cc + 1][0], s[2 * cc + 1][1]); pf.u.w = cvt_pk_bf16(s[2 * cc + 1][2], s[2 * cc + 1][3]);
#pragma unroll
            for (int et = 0; et < 4; ++et) { const bf16_t* vp = vbase + (cc * 32) * VSR + et * 16;
                const s16x4 v0 = __builtin_amdgcn_ds_read_tr16_b64_v4i16((LAS s16x4*)(LAS unsigned char*)vp), v1 = __builtin_amdgcn_ds_read_tr16_b64_v4i16((LAS s16x4*)(LAS unsigned char*)(vp + 16 * VSR));
                const bf16x8 vf = {v0[0], v0[1], v0[2], v0[3], v1[0], v1[1], v1[2], v1[3]};
                o[et] = __builtin_amdgcn_mfma_f32_16x16x32_bf16(vf, pf.v, o[et], 0, 0, 0); } }
        const float inv = __builtin_amdgcn_rcpf(den);
        bf16_t* op = qkv + qtok * QKVC + hh * 64 + 4 * g4;
#pragma unroll
        for (int et = 0; et < 4; ++et) { u32x2 wv; wv.x = cvt_pk_bf16(o[et][0] * inv, o[et][1] * inv); wv.y = cvt_pk_bf16(o[et][2] * inv, o[et][3] * inv); *(u32x2*)(op + et * 16) = wv; }
        if (g4 == 0) lse[qtok * 24 + hh] = mx * 0.6931471805599453f + logf(den);
    }
#undef ATT_DECODE
#undef ATT_PREFETCH
}

__device__ void attn_merge_phase(const Params& p, int chunk) {
    const bf16_t* og = (const bf16_t*)(((unsigned char*)ldp(38)) + OFF_A); const float* lse = (const float*)(((unsigned char*)ldp(38)) + OFF_XC); bf16_t* yb = (bf16_t*)(((unsigned char*)ldp(38)) + OFF_YA) + 512;
    const int total = MT * 64;
    for (int idx = blockIdx.x * 512 + TIDX; idx < total; idx += gridDim.x * 512) {
        const int e8 = idx & 7, j = (idx >> 3) & 7; const size_t tok = (size_t)(idx >> 6);
        const float l0 = lse[tok * 24 + j], l1 = lse[tok * 24 + 8 + j], l2 = lse[tok * 24 + 16 + j]; const float mx = fmaxf(l0, fmaxf(l1, l2));
        float w0 = __expf(l0 - mx), w1 = __expf(l1 - mx), w2 = __expf(l2 - mx); const float inv = 1.0f / (w0 + w1 + w2); w0 *= inv; w1 *= inv; w2 *= inv;
        const bf16_t* ob = og + tok * QKVC + j * 64 + e8 * 8;
        const u32x4 a = *(const u32x4*)ob, bq = *(const u32x4*)(ob + 512), cq = *(const u32x4*)(ob + 1024);
        u32x4 r;
        r.x = cvt_pk_bf16(w0 * lo_bf(a.x) + w1 * lo_bf(bq.x) + w2 * lo_bf(cq.x), w0 * hi_bf(a.x) + w1 * hi_bf(bq.x) + w2 * hi_bf(cq.x));
        r.y = cvt_pk_bf16(w0 * lo_bf(a.y) + w1 * lo_bf(bq.y) + w2 * lo_bf(cq.y), w0 * hi_bf(a.y) + w1 * hi_bf(bq.y) + w2 * hi_bf(cq.y));
        r.z = cvt_pk_bf16(w0 * lo_bf(a.z) + w1 * lo_bf(bq.z) + w2 * lo_bf(cq.z), w0 * hi_bf(a.z) + w1 * hi_bf(bq.z) + w2 * hi_bf(cq.z));
        r.w = cvt_pk_bf16(w0 * lo_bf(a.w) + w1 * lo_bf(bq.w) + w2 * lo_bf(cq.w), w0 * hi_bf(a.w) + w1 * hi_bf(bq.w) + w2 * hi_bf(cq.w));
        *(u32x4*)(yb + tok * 1536 + j * 64 + e8 * 8) = r;
    }
}

#define XB_TMO      128
#define XB_XCNT(j)  (256  + 64 * (j))
#define XB_XSUB(j)  (1280 + 64 * (j))
#define XB_XGEN(j)  (2304 + 64 * (j))
#define XB_TOP      3328
#define XB_TOPGEN   3392
#define XCD_BAR_WORDS 3456
#define XB_SPIN_CAP (1u << 22)
constexpr size_t OFF_BAR = OFF_SM + 640 * 1024;
__device__ __forceinline__ unsigned xb_ld(unsigned* p)              { return __hip_atomic_load(p, __ATOMIC_RELAXED, __HIP_MEMORY_SCOPE_AGENT); }
__device__ __forceinline__ unsigned xb_add(unsigned* p, unsigned v) { return __hip_atomic_fetch_add(p, v, __ATOMIC_RELAXED, __HIP_MEMORY_SCOPE_AGENT); }
__device__ __forceinline__ unsigned xb_xcc_id() { return (unsigned)__builtin_amdgcn_s_getreg((3 << 11) | 20) & 0xFu; }
#define XB_SPIN(cond, bar) do { unsigned _sp = 0; while (cond) { __builtin_amdgcn_s_sleep(1); \
    if ((++_sp & 255u) == 0u) { if (xb_ld(&(bar)[XB_TMO])) break; if (_sp > XB_SPIN_CAP) { atomicAdd(&(bar)[XB_TMO], 1u); break; } } } } while (0)
__device__ __forceinline__ void xcd_barrier_complete(unsigned* bar, unsigned x, unsigned& nloc, unsigned& nx) {
    const unsigned G = gridDim.x * gridDim.y * gridDim.z;
    unsigned sum, cnt, mine, sp = 0u;
    for (;;) {
        sum = 0u; cnt = 0u; mine = 0u;
#pragma unroll
        for (unsigned j = 0; j < 16; ++j) { const unsigned c = xb_ld(&bar[XB_XCNT(j)]); sum += c; cnt += (c > 0u) ? 1u : 0u; mine = (j == x) ? c : mine; }
        if (sum == G) break;
        __builtin_amdgcn_s_sleep(1);
        if ((++sp & 255u) == 0u) { if (xb_ld(&bar[XB_TMO])) break; if (sp > XB_SPIN_CAP) { atomicAdd(&bar[XB_TMO], 1u); break; } }
    }
    nloc = mine > 0u ? mine : 1u; nx = cnt > 0u ? cnt : 1u;
}
__device__ __forceinline__ void xcd_barrier() {
    asm volatile("s_waitcnt vmcnt(0)" ::: "memory");
    __syncthreads();
    if (threadIdx.x == 0) {
        unsigned* bar = (unsigned*)(((unsigned char*)ldp(38)) + OFF_BAR);
        volatile LAS unsigned* st = (volatile LAS unsigned*)(LAS unsigned char*)(g_smem + LDS_BYTES - 1024);
        const unsigned x = xb_xcc_id();
        __builtin_amdgcn_s_waitcnt(0);
        unsigned nloc = st[0], nx = st[1];
        if (nloc == 0u) { xcd_barrier_complete(bar, x, nloc, nx); st[0] = nloc; st[1] = nx; }
        const unsigned old = xb_add(&bar[XB_XSUB(x)], 1u);
        const unsigned gen = old / nloc;
        if (old + 1u == (gen + 1u) * nloc) {
            __builtin_amdgcn_fence(__ATOMIC_RELEASE, "agent");
            asm volatile("s_waitcnt vmcnt(0)" ::: "memory");
            const unsigned og = xb_add(&bar[XB_TOP], 1u);
            const unsigned tg = og / nx;
            if (og + 1u == (tg + 1u) * nx) xb_add(&bar[XB_TOPGEN], 1u);
            else XB_SPIN(xb_ld(&bar[XB_TOPGEN]) == tg, bar);
            __builtin_amdgcn_fence(__ATOMIC_ACQUIRE, "agent");
            xb_add(&bar[XB_XGEN(x)], 1u);
            asm volatile("s_waitcnt vmcnt(0)" ::: "memory");
        } else {
            XB_SPIN(xb_ld(&bar[XB_XGEN(x)]) == gen, bar);
            __builtin_amdgcn_fence(__ATOMIC_ACQUIRE, "agent");
            asm volatile("s_waitcnt vmcnt(0)" ::: "memory");
        }
    }
    __syncthreads();
}

__global__ void __launch_bounds__(512, 2) fwd_megakernel(Params p) {
    extern __shared__ __attribute__((aligned(16))) unsigned char smem[];
    if (threadIdx.x == 0) { unsigned long long* tb = (unsigned long long*)(smem + PTR_OFF);
#pragma unroll
        for (int i = 0; i < 37; ++i) tb[i] = (unsigned long long)p.in[i];
        tb[37] = (unsigned long long)p.out; tb[38] = (unsigned long long)p.ws; }
    if (threadIdx.x == 0) { volatile LAS unsigned* st = (volatile LAS unsigned*)(LAS unsigned char*)(smem + LDS_BYTES - 1024); st[0] = 0u; st[1] = 0u;
        (void)xb_add(&((unsigned*)(p.ws + OFF_BAR))[XB_XCNT(xb_xcc_id())], 1u); }
    __syncthreads();
    bf16_t* wt = (bf16_t*)(((unsigned char*)ldp(38)) + OFF_WT); bf16_t* xn = (bf16_t*)(((unsigned char*)ldp(38)) + OFF_XN); float* h = ((float*)ldp(37));
    float* part = (float*)(((unsigned char*)ldp(38)) + OFF_PART);
    unsigned char* RA = ((unsigned char*)ldp(38)) + OFF_A; unsigned char* RB = ((unsigned char*)ldp(38)) + OFF_B;
    constexpr int NSTEP = 20;
    for (int it = 0; it <= DEPTH * NSTEP; ++it) {
        const int l = it / NSTEP, s = it - l * NSTEP;
        if (l == DEPTH) { rmsnorm_phase(h, ((const float*)ldp(36)), nullptr, nullptr, h); break; }
        GDesc d; d.kind = -1; d.A = nullptr; d.Bt = nullptr; d.M = MT; d.N = 0; d.K = 1024; d.p0 = nullptr; d.p1 = nullptr; d.q0 = nullptr; d.q1 = nullptr; d.q2 = nullptr; d.q3 = nullptr; d.i0 = 0; d.i1 = 0; d.i2 = 0; d.f0 = 0.f;
        bool sync = true;
        switch (s) {
        case 0: convert_phase(smem, p, l); filter_mlp_phase(smem, l); if (l == 0) prep_phase((const float*)ldp(0), h, xn, part); break;
        case 3: case 17: sync = false; break;
        case 1: case 18: d.kind = 0; d.A = xn; d.Bt = wt + (s == 1 ? W_UP1 : W_UP2); d.N = 5632; d.K = 1024; d.p0 = RA; d.q3 = part; break;
        case 2: case 19: d.kind = 1; d.A = (const bf16_t*)RA; d.Bt = wt + (s == 2 ? W_DN1 : W_DN2); d.N = 1024; d.K = 2816; d.p0 = h; d.f0 = 0.5f; d.p1 = xn; d.q3 = part; break;
        case 4: d.kind = 2; d.A = xn; d.Bt = wt + W_HYRG; d.N = 2560; d.K = 1024; d.p0 = RA; d.i0 = HYC; d.p1 = RA + 96 * MiB; d.i1 = 1024; d.i2 = HYC; d.q3 = part; sync = false; break;
        case 5: RP(2) filter_phase(smem, p, l); break;
        case 6: filter_finalize_phase(); RP(3) { hy_transpose_phase(smem, p, l); rg_conv_phase(p, l); } break;
        case 7: case 8: RP(4) hyena_phase(smem, p, l, s - 7); break;
        case 9: ya_transpose_phase(smem); d.kind = 7; d.A = (const bf16_t*)(((unsigned char*)ldp(38)) + OFF_XC); d.Bt = wt + W_RG; d.N = 2048; d.K = 512; d.q0 = ((unsigned char*)ldp(38)) + OFF_XC; d.p0 = RB; d.p1 = RB + 64 * MiB;
                d.q1 = ((const float*)ldp(22)) + l * 1024; d.q2 = ((const float*)ldp(24)) + l * 1024; d.q3 = (const float*)(((unsigned char*)ldp(38)) + OFF_SM) + 4224; break;
        case 10: RP(13) rg_scan_phase(smem, p); break;
        case 11: d.kind = 2; d.A = xn; d.Bt = wt + W_QKV; d.N = QKVC; d.K = 1024; d.p0 = RA; d.i0 = QKVC; d.p1 = RA; d.i1 = QKVC; d.i2 = 1 << 30; d.q3 = part; break;
        case 12: attn_phase(smem, p, 0); break;
        case 13: RP(6) attn_merge_phase(p, 0); break;
        case 14: d.kind = 3; d.A = xn; d.Bt = wt + W_GATE; d.N = 3072; d.K = 1024; d.p0 = RA; d.q0 = ((const float*)ldp(27)) + l * 3072; d.q3 = part; break;
        case 15: d.kind = 4; d.A = (const bf16_t*)(((unsigned char*)ldp(38)) + OFF_YA); d.Bt = wt + W_PCAT; d.N = 1024; d.K = 1536; d.q0 = RA; d.p1 = RA + 192 * MiB; break;
        case 16: d.kind = 1; d.A = (const bf16_t*)(RA + 192 * MiB); d.Bt = wt + W_OUT; d.N = 1024; d.K = 1024; d.p0 = h; d.f0 = 1.0f; d.p1 = xn; d.q3 = part; break;
        default: break;
        }
        if (d.kind >= 0) { run_gemm(smem, d); if ((REP >> 7) & 1) { if (s == 1 || s == 18) run_gemm(smem, d); } if ((REP >> 8) & 1) { if (s == 9) run_gemm(smem, d); } if ((REP >> 9) & 1) { if (s == 14 || s == 11 || s == 4 || s == 15) run_gemm(smem, d); } }
        if (sync) { if (it == 0) cg::this_grid().sync(); else xcd_barrier(); if ((REP >> 12) & 1) xcd_barrier(); }
    }
}

extern "C" void kernel_launch(void* const* d_in, const int* in_sizes, int n_in, void* d_out, int out_size, void* d_ws, size_t ws_size, hipStream_t stream) {
    static int grid_blocks = 0;
    if (grid_blocks == 0) {
        if (n_in != 37 || out_size != MT * DM || ws_size < WS_NEED) { fprintf(stderr, "kernel_launch: unexpected shapes / workspace (%d inputs, out %d, ws %zu, need %zu)\n", n_in, out_size, ws_size, (size_t)WS_NEED); grid_blocks = -1; return; }
        int dev = 0, cus = 0, per_cu = 0;
        hipGetDevice(&dev); hipDeviceGetAttribute(&cus, hipDeviceAttributeMultiprocessorCount, dev);
        if (hipFuncSetAttribute((const void*)fwd_megakernel, hipFuncAttributeMaxDynamicSharedMemorySize, LDS_BYTES) != hipSuccess) { fprintf(stderr, "kernel_launch: hipFuncSetAttribute failed\n"); grid_blocks = -1; return; }
        if (hipOccupancyMaxActiveBlocksPerMultiprocessor(&per_cu, (const void*)fwd_megakernel, 512, LDS_BYTES) != hipSuccess || per_cu < 1) per_cu = 1;
        (void)hipGetLastError();
        grid_blocks = cus * 1;
    }
    if (grid_blocks < 0) return;
    Params p{};
    for (int i = 0; i < 37; ++i) p.in[i] = (const float*)d_in[i];
    p.out = (float*)d_out; p.ws = (unsigned char*)d_ws;
    if (hipMemsetAsync((unsigned char*)d_ws + OFF_BAR, 0, XCD_BAR_WORDS * 4, stream) != hipSuccess) { fprintf(stderr, "kernel_launch: memset failed\n"); return; }
    void* args[] = {&p};
    hipError_t e = hipLaunchCooperativeKernel((const void*)fwd_megakernel, dim3(grid_blocks), dim3(512), args, LDS_BYTES, stream);
    if (e != hipSuccess) fprintf(stderr, "cooperative launch failed: %s (grid %d)\n", hipGetErrorString(e), grid_blocks);
}
```

```cpp
#include <hip/hip_runtime.h>
#include <hip/hip_cooperative_groups.h>
#include <stdint.h>
#include <cstdio>
namespace cg = cooperative_groups;

#define LAS __attribute__((address_space(3)))
typedef unsigned short bf16_t;
typedef short bf16x8 __attribute__((ext_vector_type(8)));
typedef float f32x4 __attribute__((ext_vector_type(4)));
typedef unsigned u32x4 __attribute__((ext_vector_type(4)));
typedef unsigned u32x2 __attribute__((ext_vector_type(2)));

constexpr int DM = 1024, NB = 16, SEQ = 2048, MT = NB * SEQ, DEPTH = 4, DFF = 2816;
constexpr int HYW = 512, HYC = 1536, QKVC = 4608, RGW = 512, INC = 7168;
constexpr int MC = MT / 2;
constexpr size_t MiB = 1u << 20;
constexpr size_t W_UP1 = 0, W_DN1 = W_UP1 + 5632ull * 1024, W_HYRG = W_DN1 + 1024ull * 2816, W_QKV = W_HYRG + 2560ull * 1024,
                 W_GATE = W_QKV + 4608ull * 1024, W_PCAT = W_GATE + 3072ull * 1024,
                 W_OUT = W_PCAT + 1024ull * 1536, W_UP2 = W_OUT + 1024ull * 1024, W_DN2 = W_UP2 + 5632ull * 1024, W_RG = W_DN2 + 1024ull * 2816,
                 W_END = W_RG + 2048ull * 512;
static_assert(W_END == 30ull * 1024 * 1024, "weights");
constexpr size_t OFF_WT = 0;
constexpr size_t OFF_XN = OFF_WT + 60 * MiB;
constexpr size_t OFF_A = OFF_XN + 64 * MiB;
constexpr size_t OFF_B = OFF_A + 176 * MiB;
constexpr size_t OFF_XC = OFF_B + 128 * MiB;
constexpr size_t OFF_YA = OFF_XC + 32 * MiB, OFF_YB = OFF_YA + 32 * MiB, OFF_YC = OFF_YB + 32 * MiB;
constexpr size_t OFF_SM = OFF_YC + 32 * MiB;
constexpr size_t OFF_PART = OFF_SM + 1 * MiB;
constexpr size_t OFF_HDN = OFF_PART + 2 * MiB;
constexpr size_t WS_NEED = OFF_HDN + 1 * MiB;
constexpr int LDS_BYTES = 144 * 1024;
#ifndef REP
#define REP 0
#endif
#define RP(bit) for (int rp_ = 0; rp_ < (((REP >> (bit)) & 1) ? 2 : 1); ++rp_)

struct Params { const float* in[37]; float* out; unsigned char* ws; };

__device__ __forceinline__ int tid_opaque() { int t = threadIdx.x; asm volatile("" : "+v"(t)); return t; }
#define TIDX tid_opaque()
__device__ __forceinline__ u32x4 zero4() { unsigned z = 0; asm volatile("" : "+v"(z)); return (u32x4){z, z, z, z}; }
extern __shared__ __attribute__((aligned(16))) unsigned char g_smem[];
constexpr int PTR_OFF = LDS_BYTES - 512;
__device__ __forceinline__ const void* ldp(int i) {
    const unsigned long long v = *(const volatile unsigned long long*)(g_smem + PTR_OFF + 8 * i);
    const unsigned lo = __builtin_amdgcn_readfirstlane((unsigned)v), hi = __builtin_amdgcn_readfirstlane((unsigned)(v >> 32));
    return (const void*)(const __attribute__((address_space(1))) void*)(((unsigned long long)hi << 32) | lo);
}
__device__ __forceinline__ bf16_t f2bf(float f) { unsigned u = __float_as_uint(f); u += 0x7FFFu + ((u >> 16) & 1u); return (bf16_t)(u >> 16); }
__device__ __forceinline__ float bf2f(bf16_t b) { return __uint_as_float(((unsigned)b) << 16); }
typedef float f32x2_t __attribute__((ext_vector_type(2)));
typedef __bf16 bf16x2_t __attribute__((ext_vector_type(2)));
__device__ __forceinline__ unsigned cvt_pk_bf16(float lo, float hi) { const f32x2_t v = {lo, hi}; const bf16x2_t b = __builtin_convertvector(v, bf16x2_t); return __builtin_bit_cast(unsigned, b); }
__device__ __forceinline__ float lo_bf(unsigned w) { return __uint_as_float(w << 16); }
__device__ __forceinline__ float hi_bf(unsigned w) { return __uint_as_float(w & 0xffff0000u); }
__device__ __forceinline__ float sigmoidf_(float x) { return __builtin_amdgcn_rcpf(1.0f + __builtin_amdgcn_exp2f(-1.4426950408889634f * x)); }
__device__ __forceinline__ float sin_acc(float x, double shift) {
    double xd = (double)x + shift; const double k = rint(xd * 0.15915494309189535); double r = xd - k * 6.283185307179586;
    const double r2 = r * r; double s = -1.0 / 51090942171709440000.0;
    s = s * r2 + 1.0 / 121645100408832000.0; s = s * r2 - 1.0 / 355687428096000.0; s = s * r2 + 1.0 / 1307674368000.0; s = s * r2 - 1.0 / 6227020800.0;
    s = s * r2 + 1.0 / 39916800.0; s = s * r2 - 1.0 / 362880.0; s = s * r2 + 1.0 / 5040.0; s = s * r2 - 1.0 / 120.0; s = s * r2 + 1.0 / 6.0;
    return (float)(r - r * r2 * s);
}

namespace pg8 {
constexpr int BM = 256, BK = 64, HALF = 128, HTB = HALF * BK * 2, STAGE_BYTES = 8 * HTB, NXCD = 8, WGM = 8;
__host__ __device__ __forceinline__ int lds_byte(int r, int c) { const int st = (r >> 4) * 2 + (c >> 5), rr = r & 15, cc = c & 31, ob = rr * 64 + cc * 2; return st * 1024 + (ob ^ (((ob >> 9) & 1) << 5)); }
__host__ __device__ __forceinline__ void stage_rc(int b, int& R, int& C) { const int st = b / 1024, sb = b % 1024, swz = sb ^ (((sb >> 9) & 1) << 5); R = (st >> 1) * 16 + swz / 64; C = (st & 1) * 32 + (swz % 64) / 2; }
__host__ __device__ __forceinline__ int perm32(int rho) { const int n = rho >> 4, i = rho & 15; return 8 * (i >> 2) + 4 * n + (i & 3); }
struct Unit { int pm, pn; };
struct Gemm { const bf16_t* A; const bf16_t* Bt; int M, N, K; };
struct StaticOrder {
    int nM, nN, nwg, G, c;
    __device__ void init(int M, int N, int G_, int c_) { nM = M / BM; nN = N / BM; nwg = nM * nN; G = G_; c = c_; }
    __device__ bool next(int i, Unit& u) const {
        const long L = (long)i * G + c; if (L >= nwg) return false;
        int wgid = (int)L; { const int q = nwg / NXCD, r = nwg % NXCD, xcd = wgid % NXCD, off = wgid / NXCD; wgid = (xcd < r ? xcd * (q + 1) : r * (q + 1) + (xcd - r) * q) + off; }
        const int nig = WGM * nN, gid = wgid / nig, fm = gid * WGM, gsz = (nM - fm) < WGM ? (nM - fm) : WGM;
        u.pm = fm + ((wgid % nig) % gsz); u.pn = (wgid % nig) / gsz; return true;
    }
};

template <class Epi>
__device__ __forceinline__ void gemm_phase(LAS unsigned char* lds, const Gemm g, const StaticOrder& S, const Epi& E, const bool perm) {
    const int tid = TIDX, wid = __builtin_amdgcn_readfirstlane(tid >> 6), lane = tid & 63, wr = wid >> 2, wc = wid & 3, fr = lane & 15, fq = lane >> 4;
    const int K = g.K, nt = K / BK;
    unsigned voffA[2], voffB[2];
#pragma unroll
    for (int i = 0; i < 2; ++i) { int R, C; stage_rc(tid * 16 + i * 8192, R, C); const int Rb = perm ? ((R & ~31) + perm32(R & 31)) : R;
        voffA[i] = (unsigned)(R * K + C) * 2u; voffB[i] = (unsigned)(Rb * K + C) * 2u; }
    const size_t kstep = (size_t)(BK * 2);
    const size_t hstep = (size_t)HALF * K * 2;
    const size_t tstep = 2 * hstep;
    const unsigned ldsw = (unsigned)wid * 1024u;
    const int aoff = lds_byte(wr * 64 + fr, fq * 8), boff = lds_byte(wc * 32 + fr, fq * 8);
#define PG8_SA(b, h) (((b) * 2 + (h)) * HTB)
#define PG8_SB(b, h) ((4 + (b) * 2 + (h)) * HTB)
#define PG8_STAGE(bufoff, gbase, voff) do { _Pragma("unroll") for (int _i = 0; _i < 2; ++_i) \
        __builtin_amdgcn_global_load_lds((const unsigned*)((const char*)(gbase) + (voff)[_i]), (LAS unsigned*)(lds + (bufoff) + ldsw + _i * 8192), 16, 0, 0); } while (0)
#define PG8_LDA(dst, b, h) do { _Pragma("unroll") for (int m = 0; m < 4; ++m) _Pragma("unroll") for (int k = 0; k < 2; ++k) dst[m][k] = *(const LAS bf16x8*)(lds + PG8_SA(b, h) + aoff + m * 2048 + k * 1024); } while (0)
#define PG8_LDB(dst, b, h) do { _Pragma("unroll") for (int n = 0; n < 2; ++n) _Pragma("unroll") for (int k = 0; k < 2; ++k) dst[n][k] = *(const LAS bf16x8*)(lds + PG8_SB(b, h) + boff + n * 2048 + k * 1024); } while (0)
#define PG8_MMA(ai, bj, At, Bt) do { __builtin_amdgcn_s_setprio(1); _Pragma("unroll") for (int m = 0; m < 4; ++m) _Pragma("unroll") for (int n = 0; n < 2; ++n) _Pragma("unroll") for (int k = 0; k < 2; ++k) \
        acc[ai][bj][m][n] = __builtin_amdgcn_mfma_f32_16x16x32_bf16(Bt[n][k], At[m][k], acc[ai][bj][m][n], 0, 0, 0); __builtin_amdgcn_s_setprio(0); } while (0)
#define PG8_WAIT_V(n) asm volatile("s_waitcnt vmcnt(" #n ")" ::: "memory")
#define PG8_WAIT_L(n) asm volatile("s_waitcnt lgkmcnt(" #n ")" ::: "memory")
#define PG8_BAR __builtin_amdgcn_s_barrier()
#define PG8_SCHED __builtin_amdgcn_sched_barrier(0)
    Unit cur, nxt; int ui = 0;
    if (!S.next(0, cur)) return;
    f32x4 acc[2][2][4][2];
#pragma unroll
    for (int a = 0; a < 2; ++a)
#pragma unroll
        for (int b = 0; b < 2; ++b)
#pragma unroll
            for (int m = 0; m < 4; ++m)
#pragma unroll
                for (int n = 0; n < 2; ++n) acc[a][b][m][n] = (f32x4){0.f, 0.f, 0.f, 0.f};
    bf16x8 At[4][2], B0[2][2], B1[2][2];
    const char* cA = (const char*)g.A + (size_t)cur.pm * tstep; const char* cB = (const char*)g.Bt + (size_t)cur.pn * tstep;
    PG8_STAGE(PG8_SB(0, 0), cB, voffB); PG8_STAGE(PG8_SA(0, 0), cA, voffA); PG8_STAGE(PG8_SB(0, 1), cB + hstep, voffB); PG8_STAGE(PG8_SA(0, 1), cA + hstep, voffA);
    if (wr == 1) PG8_BAR;
    PG8_WAIT_V(4); PG8_BAR;
    PG8_STAGE(PG8_SB(1, 0), cB + kstep, voffB); PG8_STAGE(PG8_SA(1, 0), cA + kstep, voffA); PG8_STAGE(PG8_SB(1, 1), cB + hstep + kstep, voffB);
    PG8_WAIT_V(6); PG8_BAR;
    for (;;) {
        const bool has_next = S.next(ui + 1, nxt);
        const char* nA = has_next ? (const char*)g.A + (size_t)nxt.pm * tstep : cA; const char* nB = has_next ? (const char*)g.Bt + (size_t)nxt.pn * tstep : cB;
        for (int t = 0; t < nt; t += 2) {
            if (E.hook() && (t == 8 || t == 16)) E.rescale(acc, cur, t >> 4, wr, wc, fr, fq);
            const bool last = (t == nt - 2);
            const char* a1 = cA + (size_t)(t + 1) * kstep;
            const char* a2 = last ? nA : cA + (size_t)(t + 2) * kstep; const char* b2 = last ? nB : cB + (size_t)(t + 2) * kstep;
            const char* a3 = a2 + kstep; const char* b3 = b2 + kstep;
            PG8_LDB(B0, 0, 0); PG8_SCHED; PG8_LDA(At, 0, 0); PG8_STAGE(PG8_SA(1, 1), a1 + hstep, voffA);
            PG8_WAIT_L(8); PG8_BAR; PG8_WAIT_L(0); PG8_MMA(0, 0, At, B0); PG8_BAR; PG8_SCHED;
            PG8_LDB(B1, 0, 1); PG8_STAGE(PG8_SB(0, 0), b2, voffB);
            PG8_BAR; PG8_WAIT_L(0); PG8_MMA(0, 1, At, B1); PG8_BAR;
            PG8_LDA(At, 0, 1); PG8_STAGE(PG8_SA(0, 0), a2, voffA);
            PG8_BAR; PG8_WAIT_L(0); PG8_MMA(1, 0, At, B0); PG8_BAR; PG8_SCHED;
            PG8_STAGE(PG8_SB(0, 1), b2 + hstep, voffB);
            PG8_WAIT_V(6); PG8_BAR; PG8_MMA(1, 1, At, B1); PG8_BAR;
            PG8_LDB(B0, 1, 0); PG8_SCHED; PG8_LDA(At, 1, 0); PG8_STAGE(PG8_SA(0, 1), a2 + hstep, voffA);
            PG8_WAIT_L(8); PG8_BAR; PG8_WAIT_L(0); PG8_MMA(0, 0, At, B0); PG8_BAR; PG8_SCHED;
            PG8_LDB(B1, 1, 1); PG8_STAGE(PG8_SB(1, 0), b3, voffB);
            PG8_BAR; PG8_WAIT_L(0); PG8_MMA(0, 1, At, B1); PG8_BAR;
            PG8_LDA(At, 1, 1); PG8_STAGE(PG8_SA(1, 0), a3, voffA);
            PG8_BAR; PG8_WAIT_L(0); PG8_MMA(1, 0, At, B0); PG8_BAR; PG8_SCHED;
            PG8_STAGE(PG8_SB(1, 1), b3 + hstep, voffB);
            PG8_WAIT_V(6); PG8_BAR; PG8_MMA(1, 1, At, B1); PG8_BAR;
        }
        E(acc, cur, ui, wr, wc, fr, fq);
        if (!has_next) break;
#pragma unroll
        for (int a = 0; a < 2; ++a)
#pragma unroll
            for (int b = 0; b < 2; ++b)
#pragma unroll
                for (int m = 0; m < 4; ++m)
#pragma unroll
                    for (int n = 0; n < 2; ++n) acc[a][b][m][n] = (f32x4){0.f, 0.f, 0.f, 0.f};
        cur = nxt; cA = nA; cB = nB; ++ui;
    }
    PG8_WAIT_V(0);
    if (wr == 0) PG8_BAR;
    PG8_BAR;
#undef PG8_SA
#undef PG8_SB
#undef PG8_STAGE
#undef PG8_LDA
#undef PG8_LDB
#undef PG8_MMA
#undef PG8_WAIT_V
#undef PG8_WAIT_L
#undef PG8_BAR
#undef PG8_SCHED
}
}
using pg8::Unit; using pg8::HALF; using pg8::BM;
typedef const f32x4 (&AccRef)[2][2][4][2];

constexpr int RT_OFF = 128 * 1024;
__device__ __forceinline__ void row_scales(const LAS float* rt, int lrow0, float (&rr)[2][4]) {
#pragma unroll
    for (int ai = 0; ai < 2; ++ai)
#pragma unroll
        for (int m = 0; m < 4; ++m) rr[ai][m] = rt[lrow0 + ai * HALF + m * 16];
}
struct EpiSwiGLU {
    static constexpr bool PERM = false;
    bf16_t* act; const LAS float* part;
    __device__ __forceinline__ void operator()(AccRef acc, const Unit& u, int wr, int wc, int fr, int fq) const {
        const int row0 = u.pm * BM + wr * 64 + fr;
        float rr[2][4]; row_scales(part, wr * 64 + fr, rr);
#pragma unroll
        for (int ai = 0; ai < 2; ++ai)
#pragma unroll
            for (int m = 0; m < 4; ++m) { bf16_t* rowp = act + (size_t)(row0 + ai * HALF + m * 16) * DFF; const float rs = rr[ai][m];
#pragma unroll
                for (int bj = 0; bj < 2; ++bj) { const int ac = (u.pn * BM + bj * HALF + wc * 32) / 2 + 4 * fq;
                    const f32x4 gg = acc[ai][bj][m][0], uu = acc[ai][bj][m][1]; float o[4]; const float rs2 = rs * rs, nrs = -1.4426950408889634f * rs;
#pragma unroll
                    for (int i = 0; i < 4; ++i) o[i] = (rs2 * gg[i]) * uu[i] * __builtin_amdgcn_rcpf(1.0f + __builtin_amdgcn_exp2f(nrs * gg[i]));
                    u32x2 w; w.x = cvt_pk_bf16(o[0], o[1]); w.y = cvt_pk_bf16(o[2], o[3]); *(u32x2*)(rowp + ac) = w; } }
    }
};
struct EpiResid {
    static constexpr bool PERM = true;
    float* h; float scale; bf16_t* hb; float* part;
    __device__ __forceinline__ void operator()(AccRef acc, const Unit& u, int wr, int wc, int fr, int fq) const {
        const int row0 = u.pm * BM + wr * 64 + fr, col0 = u.pn * BM + wc * 32 + 8 * fq;
#pragma unroll
        for (int ai = 0; ai < 2; ++ai)
#pragma unroll
          for (int mp = 0; mp < 2; ++mp) {
            f32x4 hv[2][2][2];
#pragma unroll
            for (int mm = 0; mm < 2; ++mm) { const float* rowp = h + (size_t)(row0 + ai * HALF + (mp * 2 + mm) * 16) * DM + col0;
#pragma unroll
                for (int bj = 0; bj < 2; ++bj) { hv[mm][bj][0] = *(const f32x4*)(rowp + bj * HALF); hv[mm][bj][1] = *(const f32x4*)(rowp + bj * HALF + 4); } }
#pragma unroll
            for (int mm = 0; mm < 2; ++mm) { const int m = mp * 2 + mm; const size_t row = (size_t)(row0 + ai * HALF + m * 16); float* rowp = h + row * DM + col0; bf16_t* rowb = hb + row * DM + col0; float ss = 0.f;
#pragma unroll
                for (int bj = 0; bj < 2; ++bj) { const f32x4 a = hv[mm][bj][0] + acc[ai][bj][m][0] * scale, b = hv[mm][bj][1] + acc[ai][bj][m][1] * scale;
                    __builtin_nontemporal_store(a, (f32x4*)(rowp + bj * HALF)); __builtin_nontemporal_store(b, (f32x4*)(rowp + bj * HALF + 4));
                    ss += (a[0] * a[0] + a[1] * a[1]) + (a[2] * a[2] + a[3] * a[3]) + (b[0] * b[0] + b[1] * b[1]) + (b[2] * b[2] + b[3] * b[3]);
                    u32x4 w; w.x = cvt_pk_bf16(a[0], a[1]); w.y = cvt_pk_bf16(a[2], a[3]); w.z = cvt_pk_bf16(b[0], b[1]); w.w = cvt_pk_bf16(b[2], b[3]);
                    *(u32x4*)(rowb + bj * HALF) = w; }
                ss += __shfl_xor(ss, 16); ss += __shfl_xor(ss, 32);
                if (fq == 0) part[row * 16 + u.pn * 4 + wc] = ss; } }
    }
};
struct EpiBf16Split {
    static constexpr bool PERM = true;
    bf16_t* O0; int ld0; bf16_t* O1; int ld1; int split; const LAS float* part;
    __device__ __forceinline__ void operator()(AccRef acc, const Unit& u, int wr, int wc, int fr, int fq) const {
        const int row0 = u.pm * BM + wr * 64 + fr; int colt = u.pn * BM; bf16_t* base = O0; int ld = ld0;
        float rr[2][4]; row_scales(part, wr * 64 + fr, rr);
        if (colt >= split) { base = O1; ld = ld1; colt -= split; }
        const int col0 = colt + wc * 32 + 8 * fq;
#pragma unroll
        for (int ai = 0; ai < 2; ++ai)
#pragma unroll
            for (int m = 0; m < 4; ++m) { bf16_t* rowp = base + (size_t)(row0 + ai * HALF + m * 16) * ld + col0;
#pragma unroll
                for (int bj = 0; bj < 2; ++bj) { const f32x4 v0 = acc[ai][bj][m][0] * rr[ai][m], v1 = acc[ai][bj][m][1] * rr[ai][m];
                    u32x4 w; w.x = cvt_pk_bf16(v0[0], v0[1]); w.y = cvt_pk_bf16(v0[2], v0[3]); w.z = cvt_pk_bf16(v1[0], v1[1]); w.w = cvt_pk_bf16(v1[2], v1[3]);
                    *(u32x4*)(rowp + bj * HALF) = w; } }
    }
};
struct EpiGate {
    static constexpr bool PERM = true;
    bf16_t* O; const float* bias; const LAS float* part;
    __device__ __forceinline__ void operator()(AccRef acc, const Unit& u, int wr, int wc, int fr, int fq) const {
        const int row0 = u.pm * BM + wr * 64 + fr, col0 = u.pn * BM + wc * 32 + 8 * fq;
        float rr[2][4]; row_scales(part, wr * 64 + fr, rr);
#pragma unroll
        for (int bj = 0; bj < 2; ++bj) { const f32x4 b0 = *(const f32x4*)(bias + col0 + bj * HALF), b1 = *(const f32x4*)(bias + col0 + bj * HALF + 4);
#pragma unroll
            for (int ai = 0; ai < 2; ++ai)
#pragma unroll
                for (int m = 0; m < 4; ++m) { bf16_t* rowp = O + (size_t)(row0 + ai * HALF + m * 16) * 3072 + col0 + bj * HALF;
                    const f32x4 v0 = acc[ai][bj][m][0] * rr[ai][m] + b0, v1 = acc[ai][bj][m][1] * rr[ai][m] + b1;
                    u32x4 w; w.x = cvt_pk_bf16(sigmoidf_(v0[0]), sigmoidf_(v0[1])); w.y = cvt_pk_bf16(sigmoidf_(v0[2]), sigmoidf_(v0[3]));
                    w.z = cvt_pk_bf16(sigmoidf_(v1[0]), sigmoidf_(v1[1])); w.w = cvt_pk_bf16(sigmoidf_(v1[2]), sigmoidf_(v1[3]));
                    *(u32x4*)rowp = w; } }
    }
};
struct EpiBranchCat {
    static constexpr bool PERM = true;
    const bf16_t* gates; bf16_t* mb;
    typedef f32x4 (&AccMut)[2][2][4][2];
    __device__ __forceinline__ void rescale(AccMut acc, const Unit& u, int which, int wr, int wc, int fr, int fq) const {
        int row0 = u.pm * BM + wr * 64 + fr, col0 = u.pn * BM + wc * 32 + 8 * fq;
        asm volatile("" : "+v"(row0), "+v"(col0));
#pragma unroll
        for (int ai = 0; ai < 2; ++ai) {
            u32x4 gav[4][2], gbv[4][2];
#pragma unroll
            for (int m = 0; m < 4; ++m)
#pragma unroll
                for (int bj = 0; bj < 2; ++bj) { const bf16_t* gp = gates + (size_t)(row0 + ai * HALF + m * 16) * 3072 + which * 1024 + col0 + bj * HALF; gav[m][bj] = *(const u32x4*)gp; gbv[m][bj] = *(const u32x4*)(gp + 1024); }
#pragma unroll
            for (int m = 0; m < 4; ++m)
#pragma unroll
                for (int bj = 0; bj < 2; ++bj) { const u32x4 ga = gav[m][bj], gb = gbv[m][bj];
                    acc[ai][bj][m][0][0] *= lo_bf(ga.x) * __builtin_amdgcn_rcpf(lo_bf(gb.x)); acc[ai][bj][m][0][1] *= hi_bf(ga.x) * __builtin_amdgcn_rcpf(hi_bf(gb.x)); acc[ai][bj][m][0][2] *= lo_bf(ga.y) * __builtin_amdgcn_rcpf(lo_bf(gb.y)); acc[ai][bj][m][0][3] *= hi_bf(ga.y) * __builtin_amdgcn_rcpf(hi_bf(gb.y));
                    acc[ai][bj][m][1][0] *= lo_bf(ga.z) * __builtin_amdgcn_rcpf(lo_bf(gb.z)); acc[ai][bj][m][1][1] *= hi_bf(ga.z) * __builtin_amdgcn_rcpf(hi_bf(gb.z)); acc[ai][bj][m][1][2] *= lo_bf(ga.w) * __builtin_amdgcn_rcpf(lo_bf(gb.w)); acc[ai][bj][m][1][3] *= hi_bf(ga.w) * __builtin_amdgcn_rcpf(hi_bf(gb.w)); }
            __builtin_amdgcn_sched_barrier(0); }
    }
    __device__ __forceinline__ void operator()(AccRef acc, const Unit& u, int wr, int wc, int fr, int fq) const {
        const int row0 = u.pm * BM + wr * 64 + fr, col0 = u.pn * BM + wc * 32 + 8 * fq;
#pragma unroll
        for (int ai = 0; ai < 2; ++ai) {
            u32x4 gwv[4][2];
#pragma unroll
            for (int m = 0; m < 4; ++m)
#pragma unroll
                for (int bj = 0; bj < 2; ++bj) gwv[m][bj] = *(const u32x4*)(gates + (size_t)(row0 + ai * HALF + m * 16) * 3072 + 2048 + col0 + bj * HALF);
#pragma unroll
            for (int m = 0; m < 4; ++m) { const size_t row = (size_t)(row0 + ai * HALF + m * 16);
#pragma unroll
                for (int bj = 0; bj < 2; ++bj) { const int col = col0 + bj * HALF;
                    const u32x4 gw = gwv[m][bj];
                    const f32x4 v0 = acc[ai][bj][m][0], v1 = acc[ai][bj][m][1];
                    u32x4 w; w.x = cvt_pk_bf16(v0[0] * lo_bf(gw.x), v0[1] * hi_bf(gw.x)); w.y = cvt_pk_bf16(v0[2] * lo_bf(gw.y), v0[3] * hi_bf(gw.y));
                    w.z = cvt_pk_bf16(v1[0] * lo_bf(gw.z), v1[1] * hi_bf(gw.z)); w.w = cvt_pk_bf16(v1[2] * lo_bf(gw.w), v1[3] * hi_bf(gw.w));
                    *(u32x4*)(mb + row * DM + col) = w; } } }
    }
};
struct EpiRG {
    static constexpr bool PERM = false;
    const bf16_t* xc; bf16_t* loga; bf16_t* uu;
    const float* ba; const float* bx; const float* lam;
    __device__ __forceinline__ void operator()(AccRef acc, const Unit& u, int wr, int wc, int fr, int fq) const {
        const int row0 = u.pm * BM + wr * 64 + fr;
#pragma unroll
        for (int bj = 0; bj < 2; ++bj) { const int c = u.pn * BM + bj * HALF + wc * 32; const int dir = c >> 10; const int ch = ((c & 1023) >> 1) + 4 * fq;
            const f32x4 vba = *(const f32x4*)(ba + dir * 512 + ch), vbx = *(const f32x4*)(bx + dir * 512 + ch), vl = *(const f32x4*)(lam + dir * 512 + ch);
            const f32x4 cc = vl;
#pragma unroll
            for (int ai = 0; ai < 2; ++ai) {
                u32x2 xwv[4];
#pragma unroll
                for (int m = 0; m < 4; ++m) xwv[m] = *(const u32x2*)(xc + (size_t)(row0 + ai * HALF + m * 16) * 512 + ch);
#pragma unroll
                for (int m = 0; m < 4; ++m) { const size_t row = (size_t)(row0 + ai * HALF + m * 16);
                    const u32x2 xw = xwv[m];
                    const float xv[4] = {lo_bf(xw.x), hi_bf(xw.x), lo_bf(xw.y), hi_bf(xw.y)};
                    float la[4], uo[4];
#pragma unroll
                    for (int i = 0; i < 4; ++i) { const float r = sigmoidf_(acc[ai][bj][m][0][i] + vba[i]), gi = sigmoidf_(acc[ai][bj][m][1][i] + vbx[i]);
                        const float l = cc[i] * r; la[i] = l; const float x2 = 2.0f * l;
                        const float em1 = (x2 > -0.25f) ? x2 * (1.0f + x2 * (0.5f + x2 * (1.0f / 6.0f + x2 * (1.0f / 24.0f + x2 * (1.0f / 120.0f + x2 * (1.0f / 720.0f)))))) : (__expf(x2) - 1.0f);
                        uo[i] = __builtin_amdgcn_sqrtf(fmaxf(-em1, 0.0f)) * gi * xv[i]; }
                    u32x2 w0, w1; w0.x = cvt_pk_bf16(la[0], la[1]); w0.y = cvt_pk_bf16(la[2], la[3]); w1.x = cvt_pk_bf16(uo[0], uo[1]); w1.y = cvt_pk_bf16(uo[2], uo[3]);
                    *(u32x2*)(loga + ((size_t)dir * MT + row) * 512 + ch) = w0; *(u32x2*)(uu + ((size_t)dir * MT + row) * 512 + ch) = w1; } } }
    }
};

struct GDesc { const bf16_t* A; const bf16_t* Bt; int M, N, K, kind; void* p0; void* p1; const void* q0; const void* q1; const void* q2; const void* q3; int i0, i1, i2; float f0; };
struct EpiAny {
    GDesc d;
    __device__ __forceinline__ bool hook() const { return d.kind == 4; }
    __device__ __forceinline__ void rescale(f32x4 (&acc)[2][2][4][2], const Unit& u, int which, int wr, int wc, int fr, int fq) const { EpiBranchCat e; e.gates = (const bf16_t*)d.q0; e.mb = nullptr; e.rescale(acc, u, which, wr, wc, fr, fq); }
    __device__ __forceinline__ void operator()(AccRef acc, const Unit& u, int ui, int wr, int wc, int fr, int fq) const {
        const LAS float* rt = (const LAS float*)((LAS unsigned char*)g_smem + RT_OFF) + ui * 256;
        switch (d.kind) {
        case 0: { EpiSwiGLU e; e.act = (bf16_t*)d.p0; e.part = rt; e(acc, u, wr, wc, fr, fq); } break;
        case 1: { EpiResid e; e.h = (float*)d.p0; e.scale = d.f0; e.hb = (bf16_t*)d.p1; e.part = (float*)d.q3; e(acc, u, wr, wc, fr, fq); } break;
        case 2: { EpiBf16Split e; e.O0 = (bf16_t*)d.p0; e.ld0 = d.i0; e.O1 = (bf16_t*)d.p1; e.ld1 = d.i1; e.split = d.i2; e.part = rt; e(acc, u, wr, wc, fr, fq); } break;
        case 3: { EpiGate e; e.O = (bf16_t*)d.p0; e.bias = (const float*)d.q0; e.part = rt; e(acc, u, wr, wc, fr, fq); } break;
        case 4: { EpiBranchCat e; e.gates = (const bf16_t*)d.q0; e.mb = (bf16_t*)d.p1; e(acc, u, wr, wc, fr, fq); } break;
        default: { EpiRG e; e.xc = (const bf16_t*)d.q0; e.loga = (bf16_t*)d.p0; e.uu = (bf16_t*)d.p1; e.ba = (const float*)d.q1; e.bx = (const float*)d.q2; e.lam = (const float*)d.q3; e(acc, u, wr, wc, fr, fq); } break;
        }
    }
};
__device__ __forceinline__ void run_gemm(unsigned char* smem, const GDesc& d) {
    pg8::Gemm g; g.A = d.A; g.Bt = d.Bt; g.M = d.M; g.N = d.N; g.K = d.K;
    pg8::StaticOrder S; S.init(d.M, d.N, (int)gridDim.x, (int)blockIdx.x);
    EpiAny E; E.d = d;
    if (d.kind == 0 || d.kind == 2 || d.kind == 3) {
        const float* part = (const float*)d.q3; float* rtab = (float*)(smem + RT_OFF); int* pmtab = (int*)(smem + RT_OFF + 12 * 1024); const int tid = TIDX;
        if (tid < 16) { pg8::Unit u; pmtab[tid] = S.next(tid, u) ? u.pm : -1; }
        __syncthreads();
#pragma unroll
        for (int k = 0; k < 6; ++k) { const int idx = tid + 512 * k, i = idx >> 8, row = idx & 255; const int pm = (i < 12) ? pmtab[i] : -1;
            if (pm >= 0) { const f32x4* pp = (const f32x4*)(part + (size_t)(pm * BM + row) * 16); const f32x4 a = pp[0], b = pp[1], c = pp[2], e4 = pp[3];
                const float ss = ((a[0] + a[1]) + (a[2] + a[3])) + ((b[0] + b[1]) + (b[2] + b[3])) + ((c[0] + c[1]) + (c[2] + c[3])) + ((e4[0] + e4[1]) + (e4[2] + e4[3]));
                rtab[idx] = 1.0f / sqrtf(ss * (1.0f / DM) + 1e-6f); } }
        __syncthreads();
    }
    pg8::gemm_phase<EpiAny>((LAS unsigned char*)smem, g, S, E, !(d.kind == 0 || d.kind == 7));
    __syncthreads();
}

template <class F>
__device__ __forceinline__ void conv_tiles(float* tile, bf16_t* Bt, int R, int K, int rot, F src, int ld = 0) {
    if (ld == 0) ld = K;
    const int tid = TIDX, lane = tid & 63, w = tid >> 6;
    const int nkt = K / 64, ntile = (R / 64) * nkt;
    const int first = ((int)blockIdx.x + rot) % (int)gridDim.x;
    for (int t_ = first; t_ < ntile * ((REP & 1) + 1); t_ += gridDim.x) { const int t = t_ % ntile;
        const int r0 = (t / nkt) * 64, k0 = (t % nkt) * 64;
        __syncthreads();
#pragma unroll
        for (int i = 0; i < 8; ++i) { const int kk = i * 8 + w; tile[kk * 65 + lane] = src(k0 + kk, r0 + lane); }
        __syncthreads();
#pragma unroll
        for (int i = 0; i < 8; ++i) { const int j = i * 8 + w; Bt[(size_t)(r0 + j) * ld + k0 + lane] = f2bf(tile[lane * 65 + j]); }
    }
}

__device__ void convert_phase(unsigned char* smem, const Params& p, int l) {
    float* tile = (float*)smem; bf16_t* wt = (bf16_t*)(((unsigned char*)ldp(38)) + OFF_WT);
    const size_t uo = (size_t)l * DM * DFF;
    { const float* wg = ((const float*)ldp(2)) + uo; const float* wu = ((const float*)ldp(3)) + uo; const float* gn = ((const float*)ldp(1)) + l * DM;
      conv_tiles(tile, wt + W_UP1, 5632, 1024, 0, [=](int k, int r) { const int col = (r >> 5) * 16 + (r & 15); return gn[k] * (((r >> 4) & 1) ? wu[(size_t)k * DFF + col] : wg[(size_t)k * DFF + col]); }); }
    { const float* wd = ((const float*)ldp(4)) + uo; conv_tiles(tile, wt + W_DN1, 1024, 2816, 37, [=](int k, int r) { return wd[(size_t)k * DM + r]; }); }
    { const float* wi = ((const float*)ldp(6)) + (size_t)l * DM * INC; const float* gn = ((const float*)ldp(5)) + l * DM;
      conv_tiles(tile, wt + W_HYRG, 2560, 1024, 71, [=](int k, int r) { const int col = r < HYC ? r : r + QKVC; return gn[k] * wi[(size_t)k * INC + col]; });
      conv_tiles(tile, wt + W_QKV, 4608, 1024, 113, [=](int k, int r) { return gn[k] * wi[(size_t)k * INC + HYC + r]; }); }
    { const float* wgt = ((const float*)ldp(26)) + (size_t)l * DM * 3072; const float* gn = ((const float*)ldp(5)) + l * DM; conv_tiles(tile, wt + W_GATE, 3072, 1024, 151, [=](int k, int r) { return gn[k] * wgt[(size_t)k * 3072 + r]; }); }
    { const float* a = ((const float*)ldp(28)) + (size_t)l * 512 * DM; conv_tiles(tile, wt + W_PCAT + 0, 1024, 512, 193, [=](int k, int r) { return a[(size_t)k * DM + r]; }, 1536); }
    { const float* a = ((const float*)ldp(29)) + (size_t)l * 512 * DM; conv_tiles(tile, wt + W_PCAT + 512, 1024, 512, 211, [=](int k, int r) { return a[(size_t)k * DM + r]; }, 1536); }
    { const float* a = ((const float*)ldp(30)) + (size_t)l * 512 * DM; conv_tiles(tile, wt + W_PCAT + 1024, 1024, 512, 229, [=](int k, int r) { return a[(size_t)k * DM + r]; }, 1536); }
    { const float* a = ((const float*)ldp(31)) + (size_t)l * DM * DM; conv_tiles(tile, wt + W_OUT, 1024, 1024, 17, [=](int k, int r) { return a[(size_t)k * DM + r]; }); }
    { const float* wg = ((const float*)ldp(33)) + uo; const float* wu = ((const float*)ldp(34)) + uo; const float* gn = ((const float*)ldp(32)) + l * DM;
      conv_tiles(tile, wt + W_UP2, 5632, 1024, 53, [=](int k, int r) { const int col = (r >> 5) * 16 + (r & 15); return gn[k] * (((r >> 4) & 1) ? wu[(size_t)k * DFF + col] : wg[(size_t)k * DFF + col]); }); }
    { const float* wd = ((const float*)ldp(35)) + uo; conv_tiles(tile, wt + W_DN2, 1024, 2816, 97, [=](int k, int r) { return wd[(size_t)k * DM + r]; }); }
    { const float* wa = ((const float*)ldp(21)) + (size_t)l * 2 * 8 * 64 * 64; const float* wx = ((const float*)ldp(23)) + (size_t)l * 2 * 8 * 64 * 64;
      conv_tiles(tile, wt + W_RG, 2048, 512, 131, [=](int k, int r) { const int dir = r >> 10, cp = r & 1023, ch = (cp >> 5) * 16 + (cp & 15), hb = ch >> 6, jj = ch & 63;
          if ((k >> 6) != hb) return 0.0f; const float* src = ((cp >> 4) & 1) ? wx : wa; return src[(((size_t)dir * 8 + hb) * 64 + (k & 63)) * 64 + jj]; }); }
    float* sm = (float*)(((unsigned char*)ldp(38)) + OFF_SM);
    if (blockIdx.x == 0) { for (int i = TIDX; i < 1024; i += 512) sm[i] = 0.0f; }
    if (blockIdx.x == 2 % gridDim.x) { const float* lam = ((const float*)ldp(25)) + l * 1024; for (int i = TIDX; i < 1024; i += 512) sm[4224 + i] = -8.0f * log1pf(expf(-lam[i])); }
    if (blockIdx.x == 1 % gridDim.x) {
        const float* rb = ((const float*)ldp(18));
        for (int i = TIDX; i < 24 * 129; i += 512) { const int hh = i / 129, delta = i % 129 - 64, d = 1 << (2 * (hh >> 3)); const int rel = delta * d;
            const int n = rel < 0 ? -rel : rel; int bucket = rel > 0 ? 16 : 0;
            if (n < 8) bucket += n; else { const float nf = (float)n; int lg = 8 + (int)(logf(nf / 8.0f) / 4.852030263919617f * 8.0f); if (lg > 15) lg = 15; bucket += lg; }
            sm[1024 + i] = rb[bucket * 24 + hh]; }
    }
}

__device__ void rmsnorm_phase(const float* src, const float* g, float* copy_dst, bf16_t* xn, float* outf) {
    const int lane = TIDX & 63, gw = blockIdx.x * 8 + (TIDX >> 6), nw = gridDim.x * 8;
    f32x4 gv[4];
#pragma unroll
    for (int j = 0; j < 4; ++j) gv[j] = ((const f32x4*)g)[lane + 64 * j];
    for (int row = gw; row < MT; row += nw) {
        const f32x4* pr = (const f32x4*)(src + (size_t)row * DM); f32x4 v[4]; float ss = 0.f;
#pragma unroll
        for (int j = 0; j < 4; ++j) { v[j] = pr[lane + 64 * j]; ss += v[j][0] * v[j][0] + v[j][1] * v[j][1] + v[j][2] * v[j][2] + v[j][3] * v[j][3]; }
#pragma unroll
        for (int o = 32; o >= 1; o >>= 1) ss += __shfl_xor(ss, o);
        const float r = 1.0f / sqrtf(ss * (1.0f / DM) + 1e-6f);
#pragma unroll
        for (int j = 0; j < 4; ++j) { const f32x4 y = v[j] * r * gv[j];
            if (copy_dst) ((f32x4*)(copy_dst + (size_t)row * DM))[lane + 64 * j] = v[j];
            if (xn) { u32x2 w; w.x = cvt_pk_bf16(y[0], y[1]); w.y = cvt_pk_bf16(y[2], y[3]); ((u32x2*)(xn + (size_t)row * DM))[lane + 64 * j] = w; }
            if (outf) ((f32x4*)(outf + (size_t)row * DM))[lane + 64 * j] = y; }
    }
}

__device__ void prep_phase(const float* x, float* h, bf16_t* hb, float* part) {
    const int tid = TIDX, lane = tid & 63, gw = blockIdx.x * 8 + (tid >> 6), nw = gridDim.x * 8;
    for (int row = gw; row < MT; row += nw) {
        const f32x4* pr = (const f32x4*)(x + (size_t)row * DM); float ss = 0.f;
#pragma unroll
        for (int j = 0; j < 4; ++j) { const f32x4 v = pr[lane + 64 * j]; ss += v[0] * v[0] + v[1] * v[1] + v[2] * v[2] + v[3] * v[3];
            ((f32x4*)(h + (size_t)row * DM))[lane + 64 * j] = v;
            u32x2 w; w.x = cvt_pk_bf16(v[0], v[1]); w.y = cvt_pk_bf16(v[2], v[3]); ((u32x2*)(hb + (size_t)row * DM))[lane + 64 * j] = w; }
#pragma unroll
        for (int o = 32; o >= 1; o >>= 1) ss += __shfl_xor(ss, o);
        if (lane < 16) part[(size_t)row * 16 + lane] = (lane == 0) ? ss : 0.f;
    }
}

__device__ void filter_mlp_phase(unsigned char* smem, int l) {
    float* zz = (float*)smem;
    float* ha = zz + 8 * 36;
    float* hb = ha + 8 * 64;
    const float* w1 = ((const float*)ldp(9)) + (size_t)l * 33 * 64; const float* b1 = ((const float*)ldp(10)) + l * 64; const float* w2 = ((const float*)ldp(11)) + (size_t)l * 64 * 64; const float* b2 = ((const float*)ldp(12)) + l * 64;
    const float* w3 = ((const float*)ldp(13)) + (size_t)l * 64 * 64; const float* b3 = ((const float*)ldp(14)) + l * 64; const float* fr = ((const float*)ldp(15)) + l * 64;
    float* hdn = (float*)(((unsigned char*)ldp(38)) + OFF_HDN);
    const int tid = TIDX, u = tid & 63, ps = tid >> 6;
    for (int tile = blockIdx.x; tile < 256; tile += gridDim.x) {
        const int pos = tile * 8 + ps;
        __syncthreads();
        if (u < 33) { float f;
            if (u == 0) f = (float)pos / 2047.0f;
            else { const int bi = (u - 1) & 15; const float fb = 1e-4f + (float)bi * ((15.0f - 1e-4f) / 15.0f); const float wpos = 6.283185307179586f * (float)pos / 2048.0f; const float arg = fb * wpos;
                f = (u <= 16) ? sin_acc(arg, 1.5707963267948966) : -sin_acc(arg, 0.0); }
            zz[ps * 36 + u] = f; }
        __syncthreads();
        { float a = b1[u];
#pragma unroll 3
            for (int k = 0; k < 33; ++k) a += zz[ps * 36 + k] * w1[k * 64 + u]; ha[ps * 64 + u] = sin_acc(fr[u] * a, 0.0); }
        __syncthreads();
        { float a = b2[u];
#pragma unroll 4
            for (int k = 0; k < 64; ++k) a += ha[ps * 64 + k] * w2[k * 64 + u]; hb[ps * 64 + u] = sin_acc(fr[u] * a, 0.0); }
        __syncthreads();
        { float a = b3[u];
#pragma unroll 4
            for (int k = 0; k < 64; ++k) a += hb[ps * 64 + k] * w3[k * 64 + u]; hdn[pos * 64 + u] = sin_acc(fr[u] * a, 0.0); }
    }
}

__device__ void filter_phase(unsigned char* smem, const Params& p, int l) {
    float* h3 = (float*)smem;
    const float* wout = ((const float*)ldp(16)) + (size_t)l * 64 * 2048; const float* hdn = (const float*)(((unsigned char*)ldp(38)) + OFF_HDN);
    float* hraw = (float*)(((unsigned char*)ldp(38)) + OFF_A + 160 * MiB); float* norms = (float*)(((unsigned char*)ldp(38)) + OFF_SM);
    const int tid = TIDX;
    for (int tile = blockIdx.x; tile < 256; tile += gridDim.x) {
        const int cb = tile & 3, pb = tile >> 2;
        __syncthreads();
        ((f32x4*)h3)[tid] = ((const f32x4*)(hdn + (size_t)pb * 32 * 64))[tid];
        __syncthreads();
        const int c = tid, dir = cb >> 1, o = cb & 1;
        const float da = -4.605170185988091f / 0.3f, db = -4.605170185988091f / 1.5f; const float delta = fabsf(da + (float)c * ((db - da) / 511.0f));
        float asum = 0.f; float* dst = hraw + ((size_t)(dir * 2 + o) * 512 + c) * 2048 + pb * 32;
#pragma unroll 1
        for (int half = 0; half < 2; ++half) {
            float accv[16];
#pragma unroll
            for (int i = 0; i < 16; ++i) accv[i] = 0.f;
#pragma unroll 2
            for (int k = 0; k < 64; ++k) { const float wv = wout[(size_t)k * 2048 + cb * 512 + c];
#pragma unroll
                for (int i = 0; i < 16; ++i) accv[i] += h3[(half * 16 + i) * 64 + k] * wv; }
#pragma unroll
            for (int i = 0; i < 16; ++i) { const int pos = pb * 32 + half * 16 + i; const float t = (float)pos / 2047.0f; const float val = accv[i] * (expf(-t * delta) + 0.05f);
                dst[half * 16 + i] = val; if (!(dir == 1 && pos == 0)) asum += fabsf(val); }
        }
        norms[16384 + pb * 2048 + cb * 512 + c] = asum;
    }
}

__device__ void hy_transpose_phase(unsigned char* smem, const Params& p, int l) {
    float* tile = (float*)smem;
    const bf16_t* uhy = (const bf16_t*)(((unsigned char*)ldp(38)) + OFF_A); bf16_t* hyT = (bf16_t*)(((unsigned char*)ldp(38)) + OFF_B);
    const float* cw = ((const float*)ldp(7)) + (size_t)l * 3 * HYC; const float* cb = ((const float*)ldp(8)) + (size_t)l * HYC;
    const int tid = TIDX;
    const int ntile = (MT / 64) * (HYC / 64);
    for (int t = blockIdx.x; t < ntile; t += gridDim.x) {
        const int cblk = t % (HYC / 64), rblk = t / (HYC / 64); const int b = rblk >> 5, t0 = (rblk & 31) * 64, c0 = cblk * 64;
        __syncthreads();
        for (int e = tid; e < 66 * 8; e += 512) { const int rr = e >> 3, c8 = e & 7; const int tt = t0 - 1 + rr;
            u32x4 v = zero4();
            if (tt >= 0 && tt < SEQ) v = *(const u32x4*)(uhy + ((size_t)b * SEQ + tt) * HYC + c0 + c8 * 8);
            float* d = tile + rr * 65 + c8 * 8;
            d[0] = lo_bf(v.x); d[1] = hi_bf(v.x); d[2] = lo_bf(v.y); d[3] = hi_bf(v.y); d[4] = lo_bf(v.z); d[5] = hi_bf(v.z); d[6] = lo_bf(v.w); d[7] = hi_bf(v.w); }
        __syncthreads();
        { const int cc = tid >> 3, t8 = tid & 7, c = c0 + cc; const float w0 = cw[c], w1 = cw[HYC + c], w2 = cw[2 * HYC + c], bb = cb[c];
          float x[10];
#pragma unroll
          for (int i = 0; i < 10; ++i) x[i] = tile[(t8 * 8 + i) * 65 + cc];
          float o[8];
#pragma unroll
          for (int i = 0; i < 8; ++i) o[i] = w0 * x[i] + w1 * x[i + 1] + w2 * x[i + 2] + bb;
          u32x4 w; w.x = cvt_pk_bf16(o[0], o[1]); w.y = cvt_pk_bf16(o[2], o[3]); w.z = cvt_pk_bf16(o[4], o[5]); w.w = cvt_pk_bf16(o[6], o[7]);
          *(u32x4*)(hyT + ((size_t)c * NB + b) * SEQ + t0 + t8 * 8) = w; }
    }
}

__device__ void ya_transpose_phase(unsigned char* smem) {
    bf16_t* tile = (bf16_t*)smem;
    const bf16_t* yaT = (const bf16_t*)(((unsigned char*)ldp(38)) + OFF_A); bf16_t* ya = (bf16_t*)(((unsigned char*)ldp(38)) + OFF_YA);
    const int tid = TIDX;
    const int ntile = (MT / 64) * (HYW / 64);
    for (int t = blockIdx.x; t < ntile; t += gridDim.x) {
        const int cblk = t % (HYW / 64), rblk = t / (HYW / 64); const int b = rblk >> 5, t0 = (rblk & 31) * 64, c0 = cblk * 64;
        __syncthreads();
        { const int cc = tid >> 3, t8 = tid & 7; *(u32x4*)(tile + cc * 72 + t8 * 8) = *(const u32x4*)(yaT + ((size_t)(c0 + cc) * NB + b) * SEQ + t0 + t8 * 8); }
        __syncthreads();
        { const int tt = tid >> 3, c8 = tid & 7; unsigned short v[8];
#pragma unroll
          for (int i = 0; i < 8; ++i) v[i] = tile[(c8 * 8 + i) * 72 + tt];
          u32x4 w; w.x = (unsigned)v[0] | ((unsigned)v[1] << 16); w.y = (unsigned)v[2] | ((unsigned)v[3] << 16); w.z = (unsigned)v[4] | ((unsigned)v[5] << 16); w.w = (unsigned)v[6] | ((unsigned)v[7] << 16);
          *(u32x4*)(ya + ((size_t)b * SEQ + t0 + tt) * 1536 + c0 + c8 * 8) = w; }
    }
}

__device__ void rg_conv_phase(const Params& p, int l) {
    const bf16_t* urg = (const bf16_t*)(((unsigned char*)ldp(38)) + OFF_A + 96 * MiB); bf16_t* xc = (bf16_t*)(((unsigned char*)ldp(38)) + OFF_XC);
    const float* cw = ((const float*)ldp(19)) + (size_t)l * 4 * RGW; const float* cb = ((const float*)ldp(20)) + (size_t)l * RGW;
    const int total = (MT / 16) * 64;
    for (int idx = blockIdx.x * 512 + TIDX; idx < total; idx += gridDim.x * 512) {
        const int c8 = idx & 63, run = idx >> 6, tok0 = run * 16, t0 = tok0 & (SEQ - 1);
        float wgt[4][8], bia[8];
#pragma unroll
        for (int i = 0; i < 8; ++i) { bia[i] = cb[c8 * 8 + i];
#pragma unroll
            for (int k = 0; k < 4; ++k) wgt[k][i] = cw[k * RGW + c8 * 8 + i]; }
        u32x4 win[4];
        const bf16_t* src = urg + (size_t)tok0 * 1024 + c8 * 8;
#pragma unroll
        for (int k = 0; k < 3; ++k) { const int tt = t0 + k - 2; win[k + 1] = (tt >= 0 && tt < SEQ) ? *(const u32x4*)(src + (ptrdiff_t)(k - 2) * 1024) : zero4(); }
#pragma unroll
        for (int i = 0; i < 16; ++i) {
            win[0] = win[1]; win[1] = win[2]; win[2] = win[3];
            { const int tt = t0 + i + 1; win[3] = (tt < SEQ) ? *(const u32x4*)(src + (ptrdiff_t)(i + 1) * 1024) : zero4(); }
            float a[8];
#pragma unroll
            for (int e = 0; e < 8; ++e) a[e] = bia[e];
#pragma unroll
            for (int k = 0; k < 4; ++k) { const u32x4 xv = win[k];
                a[0] += wgt[k][0] * lo_bf(xv.x); a[1] += wgt[k][1] * hi_bf(xv.x); a[2] += wgt[k][2] * lo_bf(xv.y); a[3] += wgt[k][3] * hi_bf(xv.y);
                a[4] += wgt[k][4] * lo_bf(xv.z); a[5] += wgt[k][5] * hi_bf(xv.z); a[6] += wgt[k][6] * lo_bf(xv.w); a[7] += wgt[k][7] * hi_bf(xv.w); }
            u32x4 w; w.x = cvt_pk_bf16(a[0], a[1]); w.y = cvt_pk_bf16(a[2], a[3]); w.z = cvt_pk_bf16(a[4], a[5]); w.w = cvt_pk_bf16(a[6], a[7]);
            *(u32x4*)(xc + (size_t)(tok0 + i) * 512 + c8 * 8) = w;
        }
    }
}

__device__ void filter_finalize_phase() {
    unsigned char* ws = (unsigned char*)ldp(38);
    const float* hraw = (const float*)(ws + OFF_A + 160 * MiB); const float* norms = (const float*)(ws + OFF_SM); bf16_t* rv = (bf16_t*)(ws + OFF_YA);
    const int tid = TIDX, lane = tid & 63, gw = blockIdx.x * 8 + (tid >> 6), nw = gridDim.x * 8;
    for (int oc = gw; oc < 1024; oc += nw) {
        const int o = oc >> 9, c = oc & 511;
        float ns = norms[16384 + lane * 2048 + o * 512 + c] + norms[16384 + lane * 2048 + (2 + o) * 512 + c];
#pragma unroll
        for (int sft = 32; sft >= 1; sft >>= 1) ns += __shfl_xor(ns, sft);
        const float scale = 1.0f / (ns + 1e-6f);
        const float* kf = hraw + ((size_t)(0 * 2 + o) * 512 + c) * 2048; const float* kb = hraw + ((size_t)(1 * 2 + o) * 512 + c) * 2048;
        for (int it = 0; it < 8; ++it) { const int i0 = it * 512 + lane * 8; float v[8];
#pragma unroll
            for (int e = 0; e < 8; ++e) { const int d = 2048 - (i0 + e); float x = 0.f; if (d >= 0 && d <= 2047) x = kf[d]; else if (d < 0 && d >= -2047) x = kb[-d]; v[e] = x * scale; }
            u32x4 w; w.x = cvt_pk_bf16(v[0], v[1]); w.y = cvt_pk_bf16(v[2], v[3]); w.z = cvt_pk_bf16(v[4], v[5]); w.w = cvt_pk_bf16(v[6], v[7]);
            *(u32x4*)(rv + (size_t)oc * 4096 + i0) = w; }
    }
}

constexpr int ZS = 2056;
constexpr int FS = 4104;
__device__ void hyena_phase(unsigned char* smem, const Params& p, int l, int order) {
    bf16_t* zs = (bf16_t*)smem;
    bf16_t* fs = (bf16_t*)(smem + 16 * ZS * 2);
    unsigned char* ws = (unsigned char*)ldp(38);
    const bf16_t* hyT = (const bf16_t*)(ws + OFF_B); bf16_t* z1T = (bf16_t*)(ws + OFF_B + 96 * MiB); bf16_t* yaT = (bf16_t*)(ws + OFF_A);
    const bf16_t* rvp = (const bf16_t*)(ws + OFF_YA);
    const float* skip = ((const float*)ldp(17)) + (size_t)l * 2 * HYW + order * HYW;
    const int tid = TIDX, lane = tid & 63, w = tid >> 6, r16 = lane & 15, g4 = lane >> 4;
    for (int c = blockIdx.x; c < HYW; c += gridDim.x) {
        const bf16_t* zin = (order == 0) ? hyT + (size_t)c * NB * SEQ : z1T + (size_t)c * NB * SEQ;
        const bf16_t* gin = hyT + ((size_t)(order + 1) * HYW + c) * NB * SEQ;
        bf16_t* dst = (order == 0 ? z1T : yaT) + (size_t)c * NB * SEQ;
        const float sk = skip[c];
        __syncthreads();
        { const u32x4 rw = *(const u32x4*)(rvp + ((size_t)order * 512 + c) * 4096 + tid * 8);
          const unsigned short e[8] = {(unsigned short)(rw.x & 0xffff), (unsigned short)(rw.x >> 16), (unsigned short)(rw.y & 0xffff), (unsigned short)(rw.y >> 16),
                                       (unsigned short)(rw.z & 0xffff), (unsigned short)(rw.z >> 16), (unsigned short)(rw.w & 0xffff), (unsigned short)(rw.w >> 16)};
#pragma unroll
          for (int m = 0; m < 8; ++m) {
#pragma unroll
              for (int k = 0; k < 8; ++k) { const int x = tid * 8 + k - m; if (x >= 0) fs[m * FS + x] = e[k]; } } }
        for (int idx = tid; idx < 16 * 256; idx += 512) { const int b = idx >> 8, s8 = idx & 255; *(u32x4*)(zs + b * ZS + s8 * 8) = *(const u32x4*)(zin + (size_t)b * SEQ + s8 * 8); }
        __syncthreads();
        const int mcopy = (8 - (r16 & 7)) & 7;
        const bf16_t* fbase = fs + mcopy * FS - mcopy + 2048 - r16 + 8 * g4;
        const bf16_t* zbase = zs + r16 * ZS + 8 * g4;
        for (int mg = 0; mg < 2; ++mg) {
            const int tb = w * 256 + mg * 128;
            f32x4 acc[8];
#pragma unroll
            for (int mi = 0; mi < 8; ++mi) acc[mi] = (f32x4){0.f, 0.f, 0.f, 0.f};
            const bf16_t* fg = fbase - tb;
            bf16x8 W[8];
#pragma unroll
            for (int i = 0; i < 8; ++i) W[i] = *(const bf16x8*)(fg - 16 * i);
#pragma unroll 4
            for (int ks = 0; ks < 64; ++ks) {
                const bf16x8 bfr = *(const bf16x8*)(zbase + ks * 32);
                bf16x8 n0 = W[0], n1 = W[0];
                if (ks < 63) { n0 = *(const bf16x8*)(fg + 16 * (2 * ks + 2)); n1 = *(const bf16x8*)(fg + 16 * (2 * ks + 1)); }
#pragma unroll
                for (int mi = 0; mi < 8; ++mi) acc[mi] = __builtin_amdgcn_mfma_f32_16x16x32_bf16(W[mi], bfr, acc[mi], 0, 0, 0);
#pragma unroll
                for (int i = 7; i >= 2; --i) W[i] = W[i - 2];
                W[0] = n0; W[1] = n1;
            }
#pragma unroll
            for (int mi = 0; mi < 8; ++mi) { const int t = tb + mi * 16 + 4 * g4;
                const u32x2 gw = *(const u32x2*)(gin + (size_t)r16 * SEQ + t); const u32x2 zw = *(const u32x2*)(zs + r16 * ZS + t);
                const float gv[4] = {lo_bf(gw.x), hi_bf(gw.x), lo_bf(gw.y), hi_bf(gw.y)}; const float zv[4] = {lo_bf(zw.x), hi_bf(zw.x), lo_bf(zw.y), hi_bf(zw.y)};
                float o[4];
#pragma unroll
                for (int i = 0; i < 4; ++i) o[i] = gv[i] * (acc[mi][i] + sk * zv[i]);
                u32x2 wv; wv.x = cvt_pk_bf16(o[0], o[1]); wv.y = cvt_pk_bf16(o[2], o[3]); *(u32x2*)(dst + (size_t)r16 * SEQ + t) = wv; }
        }
    }
}

__device__ __forceinline__ float gelu_tanh_(float gx) { const float inner = 0.7978845608028654f * (gx + 0.044715f * gx * gx * gx); const float th = 1.0f - 2.0f * __builtin_amdgcn_rcpf(1.0f + __expf(2.0f * inner)); return 0.5f * gx * (1.0f + th); }
__device__ void rg_scan_phase(unsigned char* smem, const Params& p) {
    float* carr = (float*)smem;
    unsigned char* ws = (unsigned char*)ldp(38);
    const bf16_t* loga = (const bf16_t*)(ws + OFF_B); const bf16_t* uu = (const bf16_t*)(ws + OFF_B + 64 * MiB);
    const bf16_t* urg = (const bf16_t*)(ws + OFF_A + 96 * MiB); bf16_t* yc = (bf16_t*)(ws + OFF_YA); bf16_t* hfb = (bf16_t*)(ws + OFF_XC);
    const int tid = TIDX, cp = tid & 31, seg = tid >> 5;
    for (int tile = blockIdx.x; tile < NB * 8; tile += gridDim.x) {
        const int b = tile >> 3, j = (tile & 7) * 64 + 2 * cp;
        const size_t base = ((size_t)b * SEQ + seg * 128) * 512 + j;
        const bf16_t* la0 = loga + base; const bf16_t* u0 = uu + base; const bf16_t* la1 = loga + (size_t)MT * 512 + base; const bf16_t* u1 = uu + (size_t)MT * 512 + base;
        float A0x = 1.f, H0x = 0.f, A0y = 1.f, H0y = 0.f, A1x = 1.f, H1x = 0.f, A1y = 1.f, H1y = 0.f;
#pragma unroll 8
        for (int i = 0; i < 128; ++i) { const int tb = 127 - i;
            const unsigned l0 = *(const unsigned*)(la0 + (size_t)i * 512), v0 = *(const unsigned*)(u0 + (size_t)i * 512), l1 = *(const unsigned*)(la1 + (size_t)tb * 512), v1 = *(const unsigned*)(u1 + (size_t)tb * 512);
            const float a0x = __expf(lo_bf(l0)), a0y = __expf(hi_bf(l0)), a1x = __expf(lo_bf(l1)), a1y = __expf(hi_bf(l1));
            H0x = a0x * H0x + lo_bf(v0); A0x *= a0x; H0y = a0y * H0y + hi_bf(v0); A0y *= a0y;
            H1x = a1x * H1x + lo_bf(v1); A1x *= a1x; H1y = a1y * H1y + hi_bf(v1); A1y *= a1y; }
        __syncthreads();
        { float* c0 = carr + ((0 * 16 + seg) * 64 + 2 * cp) * 2; c0[0] = A0x; c0[1] = H0x; c0[2] = A0y; c0[3] = H0y;
          float* c1 = carr + ((1 * 16 + seg) * 64 + 2 * cp) * 2; c1[0] = A1x; c1[1] = H1x; c1[2] = A1y; c1[3] = H1y; }
        __syncthreads();
        float hfx = 0.f, hfy = 0.f, hbx = 0.f, hby = 0.f;
        for (int s = 0; s < seg; ++s) { const float* c0 = carr + ((0 * 16 + s) * 64 + 2 * cp) * 2; hfx = c0[0] * hfx + c0[1]; hfy = c0[2] * hfy + c0[3]; }
        for (int s = 15; s > seg; --s) { const float* c1 = carr + ((1 * 16 + s) * 64 + 2 * cp) * 2; hbx = c1[0] * hbx + c1[1]; hby = c1[2] * hby + c1[3]; }
        bf16_t* hfp = hfb + base;
#pragma unroll 8
        for (int i = 0; i < 128; ++i) { const unsigned l0 = *(const unsigned*)(la0 + (size_t)i * 512), v0 = *(const unsigned*)(u0 + (size_t)i * 512);
            hfx = __expf(lo_bf(l0)) * hfx + lo_bf(v0); hfy = __expf(hi_bf(l0)) * hfy + hi_bf(v0); *(unsigned*)(hfp + (size_t)i * 512) = cvt_pk_bf16(hfx, hfy); }
        const bf16_t* gp = urg + ((size_t)b * SEQ + seg * 128) * 1024 + 512 + j; bf16_t* yo = yc + ((size_t)b * SEQ + seg * 128) * 1536 + 1024 + j;
#pragma unroll 8
        for (int i = 0; i < 128; ++i) { const int tt = 127 - i; const unsigned l1 = *(const unsigned*)(la1 + (size_t)tt * 512), v1 = *(const unsigned*)(u1 + (size_t)tt * 512);
            hbx = __expf(lo_bf(l1)) * hbx + lo_bf(v1); hby = __expf(hi_bf(l1)) * hby + hi_bf(v1);
            const unsigned gw = *(const unsigned*)(gp + (size_t)tt * 1024), hw = *(const unsigned*)(hfp + (size_t)tt * 512);
            *(unsigned*)(yo + (size_t)tt * 1536) = cvt_pk_bf16((lo_bf(hw) + hbx) * gelu_tanh_(lo_bf(gw)), (hi_bf(hw) + hby) * gelu_tanh_(hi_bf(gw))); }
    }
}

constexpr int KST = 72, VSR = 72, AKR = 272;
typedef short s16x4 __attribute__((ext_vector_type(4)));
__device__ void attn_phase(unsigned char* smem, const Params& p, int chunk) {
    bf16_t* qkv = (bf16_t*)(((unsigned char*)ldp(38)) + OFF_A); float* lse = (float*)(((unsigned char*)ldp(38)) + OFF_XC);
    const float* biastab = (const float*)(((unsigned char*)ldp(38)) + OFF_SM) + 1024;
    const int tid = TIDX, lane = tid & 63, w = tid >> 6, half = w >> 2, qs = w & 3, r16 = lane & 15, g4 = lane >> 4;
    bf16_t* Ks = (bf16_t*)smem; bf16_t* Vs = (bf16_t*)(smem + AKR * KST * 2); float* bs = (float*)(smem + AKR * KST * 2 + AKR * VSR * 2);
    const int npair = NB * 24 * 32 / 2;
    u32x4 kreg[5], vreg[5]; bf16x8 qn[2]; float bn = 0.f;
#define ATT_DECODE(pr) const int tile0 = (pr) * 2; const int qb0 = tile0 & 31, hh = (tile0 >> 5) % 24, b = tile0 / (32 * 24); \
        const int grp = hh >> 3, dsh = 2 * grp, nbk = 32 >> dsh, Ls = SEQ >> dsh; const int res = qb0 / nbk, n0 = qb0 % nbk, n = n0 + half; const size_t brow = (size_t)b * SEQ;
#define ATT_PREFETCH(pr) do { ATT_DECODE(pr) \
        _Pragma("unroll") for (int it = 0; it < 5; ++it) { const int chunkid = tid + 512 * it; const int key = chunkid >> 3, part = chunkid & 7; const int kp = n0 * 64 + key - 64; \
            kreg[it] = zero4(); vreg[it] = kreg[it]; \
            if (chunkid < AKR * 8 && key < 256 && kp >= 0 && kp < Ls) { const size_t tok = brow + ((size_t)kp << dsh) + res; const bf16_t* src = qkv + tok * QKVC + hh * 64 + part * 8; kreg[it] = *(const u32x4*)(src + 1536); vreg[it] = *(const u32x4*)(src + 3072); } } \
        { const int qp = n * 64 + qs * 16 + r16; const size_t qtok = brow + ((size_t)qp << dsh) + res; \
          _Pragma("unroll") for (int ks = 0; ks < 2; ++ks) qn[ks] = *(const bf16x8*)(qkv + qtok * QKVC + hh * 64 + ks * 32 + g4 * 8); } \
        bn = (tid < 129) ? biastab[hh * 129 + tid] * 1.4426950408889634f : 0.f; } while (0)
    const int nrep = ((REP >> 5) & 1) + 1;
    int pair_ = blockIdx.x;
    if (pair_ < npair * nrep) ATT_PREFETCH(pair_ % npair);
    for (; pair_ < npair * nrep; pair_ += gridDim.x) { const int pair = pair_ % npair;
        ATT_DECODE(pair)
        __syncthreads();
#pragma unroll
        for (int it = 0; it < 5; ++it) { const int chunkid = tid + 512 * it; if (chunkid < AKR * 8) { const int key = chunkid >> 3, part = chunkid & 7;
            *(u32x4*)(Ks + key * KST + part * 8) = kreg[it]; *(u32x4*)(Vs + key * VSR + part * 8) = vreg[it]; } }
        if (tid < 129) bs[tid] = bn;
        bf16x8 qf[2]; qf[0] = qn[0]; qf[1] = qn[1];
        __syncthreads();
        if (pair_ + (int)gridDim.x < npair * nrep) ATT_PREFETCH((pair_ + (int)gridDim.x) % npair);
        const int hoff = 64 * half;
        const int qi = qs * 16 + r16; const int qp = n * 64 + qi; const size_t qtok = brow + ((size_t)qp << dsh) + res;
        int lo = -64, hi = 64;
        if (n == 0) lo = max(-64, -qi);
        if (n == nbk - 1) hi = min(64, 63 - qi);
        const int cbase = 4 * g4 - r16 - 64;
        const unsigned ub = (unsigned)(cbase - lo), rng = (unsigned)(hi - lo);
        const float* bl = bs + (cbase + 64);
        f32x4 s[10];
#pragma unroll
        for (int kt = 0; kt < 9; ++kt) { s[kt] = (f32x4){0.f, 0.f, 0.f, 0.f};
#pragma unroll
            for (int ks = 0; ks < 2; ++ks) { const bf16x8 kfr = *(const bf16x8*)(Ks + (hoff + qs * 16 + kt * 16 + r16) * KST + ks * 32 + g4 * 8); s[kt] = __builtin_amdgcn_mfma_f32_16x16x32_bf16(kfr, qf[ks], s[kt], 0, 0, 0); } }
        s[9] = (f32x4){0.f, 0.f, 0.f, 0.f};
        float mx = -1e30f;
#pragma unroll
        for (int kt = 0; kt < 9; ++kt)
#pragma unroll
            for (int i = 0; i < 4; ++i) { const bool valid = (ub + (unsigned)(16 * kt + i)) <= rng;
                const float v = valid ? __builtin_fmaf(s[kt][i], 0.125f * 1.4426950408889634f, bl[16 * kt + i]) : -1e30f; s[kt][i] = v; mx = fmaxf(mx, v); }
        mx = fmaxf(mx, __shfl_xor(mx, 16)); mx = fmaxf(mx, __shfl_xor(mx, 32));
        float den = 0.f;
#pragma unroll
        for (int kt = 0; kt < 9; ++kt)
#pragma unroll
            for (int i = 0; i < 4; ++i) { const float e = __builtin_amdgcn_exp2f(s[kt][i] - mx); s[kt][i] = e; den += e; }
        den += __shfl_xor(den, 16); den += __shfl_xor(den, 32);
        f32x4 o[4];
#pragma unroll
        for (int et = 0; et < 4; ++et) o[et] = (f32x4){0.f, 0.f, 0.f, 0.f};
        const bf16_t* vbase = Vs + (hoff + qs * 16 + 4 * g4 + (r16 >> 2)) * VSR + 4 * (r16 & 3);
#pragma unroll
        for (int cc = 0; cc < 5; ++cc) {
            union { u32x4 u; bf16x8 v; } pf; pf.u.x = cvt_pk_bf16(s[2 * cc][0], s[2 * cc][1]); pf.u.y = cvt_pk_bf16(s[2 * cc][2], s[2 * cc][3]);
            pf.u.z = cvt_pk_bf16(s[2 * cc + 1][0], s[2 * cc + 1][1]); pf.u.w = cvt_pk_bf16(s[2 * cc + 1][2], s[2 * cc + 1][3]);
#pragma unroll
            for (int et = 0; et < 4; ++et) { const bf16_t* vp = vbase + (cc * 32) * VSR + et * 16;
                const s16x4 v0 = __builtin_amdgcn_ds_read_tr16_b64_v4i16((LAS s16x4*)(LAS unsigned char*)vp), v1 = __builtin_amdgcn_ds_read_tr16_b64_v4i16((LAS s16x4*)(LAS unsigned char*)(vp + 16 * VSR));
                const bf16x8 vf = {v0[0], v0[1], v0[2], v0[3], v1[0], v1[1], v1[2], v1[3]};
                o[et] = __builtin_amdgcn_mfma_f32_16x16x32_bf16(vf, pf.v, o[et], 0, 0, 0); } }
        const float inv = __builtin_amdgcn_rcpf(den);
        bf16_t* op = qkv + qtok * QKVC + hh * 64 + 4 * g4;
#pragma unroll
        for (int et = 0; et < 4; ++et) { u32x2 wv; wv.x = cvt_pk_bf16(o[et][0] * inv, o[et][1] * inv); wv.y = cvt_pk_bf16(o[et][2] * inv, o[et][3] * inv); *(u32x2*)(op + et * 16) = wv; }
        if (g4 == 0) lse[qtok * 24 + hh] = mx * 0.6931471805599453f + logf(den);
    }
#undef ATT_DECODE
#undef ATT_PREFETCH
}

__device__ void attn_merge_phase(const Params& p, int chunk) {
    const bf16_t* og = (const bf16_t*)(((unsigned char*)ldp(38)) + OFF_A); const float* lse = (const float*)(((unsigned char*)ldp(38)) + OFF_XC); bf16_t* yb = (bf16_t*)(((unsigned char*)ldp(38)) + OFF_YA) + 512;
    const int total = MT * 64;
    for (int idx = blockIdx.x * 512 + TIDX; idx < total; idx += gridDim.x * 512) {
        const int e8 = idx & 7, j = (idx >> 3) & 7; const size_t tok = (size_t)(idx >> 6);
        const float l0 = lse[tok * 24 + j], l1 = lse[tok * 24 + 8 + j], l2 = lse[tok * 24 + 16 + j]; const float mx = fmaxf(l0, fmaxf(l1, l2));
        float w0 = __expf(l0 - mx), w1 = __expf(l1 - mx), w2 = __expf(l2 - mx); const float inv = 1.0f / (w0 + w1 + w2); w0 *= inv; w1 *= inv; w2 *= inv;
        const bf16_t* ob = og + tok * QKVC + j * 64 + e8 * 8;
        const u32x4 a = *(const u32x4*)ob, bq = *(const u32x4*)(ob + 512), cq = *(const u32x4*)(ob + 1024);
        u32x4 r;
        r.x = cvt_pk_bf16(w0 * lo_bf(a.x) + w1 * lo_bf(bq.x) + w2 * lo_bf(cq.x), w0 * hi_bf(a.x) + w1 * hi_bf(bq.x) + w2 * hi_bf(cq.x));
        r.y = cvt_pk_bf16(w0 * lo_bf(a.y) + w1 * lo_bf(bq.y) + w2 * lo_bf(cq.y), w0 * hi_bf(a.y) + w1 * hi_bf(bq.y) + w2 * hi_bf(cq.y));
        r.z = cvt_pk_bf16(w0 * lo_bf(a.z) + w1 * lo_bf(bq.z) + w2 * lo_bf(cq.z), w0 * hi_bf(a.z) + w1 * hi_bf(bq.z) + w2 * hi_bf(cq.z));
        r.w = cvt_pk_bf16(w0 * lo_bf(a.w) + w1 * lo_bf(bq.w) + w2 * lo_bf(cq.w), w0 * hi_bf(a.w) + w1 * hi_bf(bq.w) + w2 * hi_bf(cq.w));
        *(u32x4*)(yb + tok * 1536 + j * 64 + e8 * 8) = r;
    }
}

#define XB_TMO      128
#define XB_XCNT(j)  (256  + 64 * (j))
#define XB_XSUB(j)  (1280 + 64 * (j))
#define XB_XGEN(j)  (2304 + 64 * (j))
#define XB_TOP      3328
#define XB_TOPGEN   3392
#define XCD_BAR_WORDS 3456
#define XB_SPIN_CAP (1u << 22)
constexpr size_t OFF_BAR = OFF_SM + 640 * 1024;
__device__ __forceinline__ unsigned xb_ld(unsigned* p)              { return __hip_atomic_load(p, __ATOMIC_RELAXED, __HIP_MEMORY_SCOPE_AGENT); }
__device__ __forceinline__ unsigned xb_add(unsigned* p, unsigned v) { return __hip_atomic_fetch_add(p, v, __ATOMIC_RELAXED, __HIP_MEMORY_SCOPE_AGENT); }
__device__ __forceinline__ unsigned xb_xcc_id() { return (unsigned)__builtin_amdgcn_s_getreg((3 << 11) | 20) & 0xFu; }
#define XB_SPIN(cond, bar) do { unsigned _sp = 0; while (cond) { __builtin_amdgcn_s_sleep(1); \
    if ((++_sp & 255u) == 0u) { if (xb_ld(&(bar)[XB_TMO])) break; if (_sp > XB_SPIN_CAP) { atomicAdd(&(bar)[XB_TMO], 1u); break; } } } } while (0)
__device__ __forceinline__ void xcd_barrier_complete(unsigned* bar, unsigned x, unsigned& nloc, unsigned& nx) {
    const unsigned G = gridDim.x * gridDim.y * gridDim.z;
    unsigned sum, cnt, mine, sp = 0u;
    for (;;) {
        sum = 0u; cnt = 0u; mine = 0u;
#pragma unroll
        for (unsigned j = 0; j < 16; ++j) { const unsigned c = xb_ld(&bar[XB_XCNT(j)]); sum += c; cnt += (c > 0u) ? 1u : 0u; mine = (j == x) ? c : mine; }
        if (sum == G) break;
        __builtin_amdgcn_s_sleep(1);
        if ((++sp & 255u) == 0u) { if (xb_ld(&bar[XB_TMO])) break; if (sp > XB_SPIN_CAP) { atomicAdd(&bar[XB_TMO], 1u); break; } }
    }
    nloc = mine > 0u ? mine : 1u; nx = cnt > 0u ? cnt : 1u;
}
__device__ __forceinline__ void xcd_barrier() {
    asm volatile("s_waitcnt vmcnt(0)" ::: "memory");
    __syncthreads();
    if (threadIdx.x == 0) {
        unsigned* bar = (unsigned*)(((unsigned char*)ldp(38)) + OFF_BAR);
        volatile LAS unsigned* st = (volatile LAS unsigned*)(LAS unsigned char*)(g_smem + LDS_BYTES - 1024);
        const unsigned x = xb_xcc_id();
        __builtin_amdgcn_s_waitcnt(0);
        unsigned nloc = st[0], nx = st[1];
        if (nloc == 0u) { xcd_barrier_complete(bar, x, nloc, nx); st[0] = nloc; st[1] = nx; }
        const unsigned old = xb_add(&bar[XB_XSUB(x)], 1u);
        const unsigned gen = old / nloc;
        if (old + 1u == (gen + 1u) * nloc) {
            __builtin_amdgcn_fence(__ATOMIC_RELEASE, "agent");
            asm volatile("s_waitcnt vmcnt(0)" ::: "memory");
            const unsigned og = xb_add(&bar[XB_TOP], 1u);
            const unsigned tg = og / nx;
            if (og + 1u == (tg + 1u) * nx) xb_add(&bar[XB_TOPGEN], 1u);
            else XB_SPIN(xb_ld(&bar[XB_TOPGEN]) == tg, bar);
            __builtin_amdgcn_fence(__ATOMIC_ACQUIRE, "agent");
            xb_add(&bar[XB_XGEN(x)], 1u);
            asm volatile("s_waitcnt vmcnt(0)" ::: "memory");
        } else {
            XB_SPIN(xb_ld(&bar[XB_XGEN(x)]) == gen, bar);
            __builtin_amdgcn_fence(__ATOMIC_ACQUIRE, "agent");
            asm volatile("s_waitcnt vmcnt(0)" ::: "memory");
        }
    }
    __syncthreads();
}

__global__ void __launch_bounds__(512, 2) fwd_megakernel(Params p) {
    extern __shared__ __attribute__((aligned(16))) unsigned char smem[];
    if (threadIdx.x == 0) { unsigned long long* tb = (unsigned long long*)(smem + PTR_OFF);
#pragma unroll
        for (int i = 0; i < 37; ++i) tb[i] = (unsigned long long)p.in[i];
        tb[37] = (unsigned long long)p.out; tb[38] = (unsigned long long)p.ws; }
    if (threadIdx.x == 0) { volatile LAS unsigned* st = (volatile LAS unsigned*)(LAS unsigned char*)(smem + LDS_BYTES - 1024); st[0] = 0u; st[1] = 0u;
        (void)xb_add(&((unsigned*)(p.ws + OFF_BAR))[XB_XCNT(xb_xcc_id())], 1u); }
    __syncthreads();
    bf16_t* wt = (bf16_t*)(((unsigned char*)ldp(38)) + OFF_WT); bf16_t* xn = (bf16_t*)(((unsigned char*)ldp(38)) + OFF_XN); float* h = ((float*)ldp(37));
    float* part = (float*)(((unsigned char*)ldp(38)) + OFF_PART);
    unsigned char* RA = ((unsigned char*)ldp(38)) + OFF_A; unsigned char* RB = ((unsigned char*)ldp(38)) + OFF_B;
    constexpr int NSTEP = 20;
    for (int it = 0; it <= DEPTH * NSTEP; ++it) {
        const int l = it / NSTEP, s = it - l * NSTEP;
        if (l == DEPTH) { rmsnorm_phase(h, ((const float*)ldp(36)), nullptr, nullptr, h); break; }
        GDesc d; d.kind = -1; d.A = nullptr; d.Bt = nullptr; d.M = MT; d.N = 0; d.K = 1024; d.p0 = nullptr; d.p1 = nullptr; d.q0 = nullptr; d.q1 = nullptr; d.q2 = nullptr; d.q3 = nullptr; d.i0 = 0; d.i1 = 0; d.i2 = 0; d.f0 = 0.f;
        bool sync = true;
        switch (s) {
        case 0: convert_phase(smem, p, l); filter_mlp_phase(smem, l); if (l == 0) prep_phase((const float*)ldp(0), h, xn, part); break;
        case 3: case 17: sync = false; break;
        case 1: case 18: d.kind = 0; d.A = xn; d.Bt = wt + (s == 1 ? W_UP1 : W_UP2); d.N = 5632; d.K = 1024; d.p0 = RA; d.q3 = part; break;
        case 2: case 19: d.kind = 1; d.A = (const bf16_t*)RA; d.Bt = wt + (s == 2 ? W_DN1 : W_DN2); d.N = 1024; d.K = 2816; d.p0 = h; d.f0 = 0.5f; d.p1 = xn; d.q3 = part; break;
        case 4: d.kind = 2; d.A = xn; d.Bt = wt + W_HYRG; d.N = 2560; d.K = 1024; d.p0 = RA; d.i0 = HYC; d.p1 = RA + 96 * MiB; d.i1 = 1024; d.i2 = HYC; d.q3 = part; sync = false; break;
        case 5: RP(2) filter_phase(smem, p, l); break;
        case 6: filter_finalize_phase(); RP(3) { hy_transpose_phase(smem, p, l); rg_conv_phase(p, l); } break;
        case 7: case 8: RP(4) hyena_phase(smem, p, l, s - 7); break;
        case 9: ya_transpose_phase(smem); d.kind = 7; d.A = (const bf16_t*)(((unsigned char*)ldp(38)) + OFF_XC); d.Bt = wt + W_RG; d.N = 2048; d.K = 512; d.q0 = ((unsigned char*)ldp(38)) + OFF_XC; d.p0 = RB; d.p1 = RB + 64 * MiB;
                d.q1 = ((const float*)ldp(22)) + l * 1024; d.q2 = ((const float*)ldp(24)) + l * 1024; d.q3 = (const float*)(((unsigned char*)ldp(38)) + OFF_SM) + 4224; break;
        case 10: RP(13) rg_scan_phase(smem, p); break;
        case 11: d.kind = 2; d.A = xn; d.Bt = wt + W_QKV; d.N = QKVC; d.K = 1024; d.p0 = RA; d.i0 = QKVC; d.p1 = RA; d.i1 = QKVC; d.i2 = 1 << 30; d.q3 = part; break;
        case 12: attn_phase(smem, p, 0); break;
        case 13: RP(6) attn_merge_phase(p, 0); break;
        case 14: d.kind = 3; d.A = xn; d.Bt = wt + W_GATE; d.N = 3072; d.K = 1024; d.p0 = RA; d.q0 = ((const float*)ldp(27)) + l * 3072; d.q3 = part; break;
        case 15: d.kind = 4; d.A = (const bf16_t*)(((unsigned char*)ldp(38)) + OFF_YA); d.Bt = wt + W_PCAT; d.N = 1024; d.K = 1536; d.q0 = RA; d.p1 = RA + 192 * MiB; break;
        case 16: d.kind = 1; d.A = (const bf16_t*)(RA + 192 * MiB); d.Bt = wt + W_OUT; d.N = 1024; d.K = 1024; d.p0 = h; d.f0 = 1.0f; d.p1 = xn; d.q3 = part; break;
        default: break;
        }
        if (d.kind >= 0) { run_gemm(smem, d); if ((REP >> 7) & 1) { if (s == 1 || s == 18) run_gemm(smem, d); } if ((REP >> 8) & 1) { if (s == 9) run_gemm(smem, d); } if ((REP >> 9) & 1) { if (s == 14 || s == 11 || s == 4 || s == 15) run_gemm(smem, d); } }
        if (sync) { if (it == 0) cg::this_grid().sync(); else xcd_barrier(); if ((REP >> 12) & 1) xcd_barrier(); }
    }
}

extern "C" void kernel_launch(void* const* d_in, const int* in_sizes, int n_in, void* d_out, int out_size, void* d_ws, size_t ws_size, hipStream_t stream) {
    static int grid_blocks = 0;
    if (grid_blocks == 0) {
        if (n_in != 37 || out_size != MT * DM || ws_size < WS_NEED) { fprintf(stderr, "kernel_launch: unexpected shapes / workspace (%d inputs, out %d, ws %zu, need %zu)\n", n_in, out_size, ws_size, (size_t)WS_NEED); grid_blocks = -1; return; }
        int dev = 0, cus = 0, per_cu = 0;
        hipGetDevice(&dev); hipDeviceGetAttribute(&cus, hipDeviceAttributeMultiprocessorCount, dev);
        if (hipFuncSetAttribute((const void*)fwd_megakernel, hipFuncAttributeMaxDynamicSharedMemorySize, LDS_BYTES) != hipSuccess) { fprintf(stderr, "kernel_launch: hipFuncSetAttribute failed\n"); grid_blocks = -1; return; }
        if (hipOccupancyMaxActiveBlocksPerMultiprocessor(&per_cu, (const void*)fwd_megakernel, 512, LDS_BYTES) != hipSuccess || per_cu < 1) per_cu = 1;
        (void)hipGetLastError();
        grid_blocks = cus * 1;
    }
    if (grid_blocks < 0) return;
    Params p{};
    for (int i = 0; i < 37; ++i) p.in[i] = (const float*)d_in[i];
    p.out = (float*)d_out; p.ws = (unsigned char*)d_ws;
    if (hipMemsetAsync((unsigned char*)d_ws + OFF_BAR, 0, XCD_BAR_WORDS * 4, stream) != hipSuccess) { fprintf(stderr, "kernel_launch: memset failed\n"); return; }
    void* args[] = {&p};
    hipError_t e = hipLaunchCooperativeKernel((const void*)fwd_megakernel, dim3(grid_blocks), dim3(512), args, LDS_BYTES, stream);
    if (e != hipSuccess) fprintf(stderr, "cooperative launch failed: %s (grid %d)\n", hipGetErrorString(e), grid_blocks);
}
```

```cpp
#include <hip/hip_runtime.h>
#include <hip/hip_cooperative_groups.h>
#include <stdint.h>
#include <cstdio>
namespace cg = cooperative_groups;

#define LAS __attribute__((address_space(3)))
typedef unsigned short bf16_t;
typedef short bf16x8 __attribute__((ext_vector_type(8)));
typedef float f32x4 __attribute__((ext_vector_type(4)));
typedef unsigned u32x4 __attribute__((ext_vector_type(4)));
typedef unsigned u32x2 __attribute__((ext_vector_type(2)));

constexpr int DM = 1024, NB = 16, SEQ = 2048, MT = NB * SEQ, DEPTH = 4, DFF = 2816;
constexpr int HYW = 512, HYC = 1536, QKVC = 4608, RGW = 512, INC = 7168;
constexpr int MC = MT / 2;
constexpr size_t MiB = 1u << 20;
constexpr size_t W_UP1 = 0, W_DN1 = W_UP1 + 5632ull * 1024, W_HYRG = W_DN1 + 1024ull * 2816, W_QKV = W_HYRG + 2560ull * 1024,
                 W_GATE = W_QKV + 4608ull * 1024, W_PCAT = W_GATE + 3072ull * 1024,
                 W_OUT = W_PCAT + 1024ull * 1536, W_UP2 = W_OUT + 1024ull * 1024, W_DN2 = W_UP2 + 5632ull * 1024, W_RG = W_DN2 + 1024ull * 2816,
                 W_END = W_RG + 2048ull * 512;
static_assert(W_END == 30ull * 1024 * 1024, "weights");
constexpr size_t OFF_WT = 0;
constexpr size_t OFF_XN = OFF_WT + 60 * MiB;
constexpr size_t OFF_A = OFF_XN + 64 * MiB;
constexpr size_t OFF_B = OFF_A + 176 * MiB;
constexpr size_t OFF_XC = OFF_B + 128 * MiB;
constexpr size_t OFF_YA = OFF_XC + 32 * MiB, OFF_YB = OFF_YA + 32 * MiB, OFF_YC = OFF_YB + 32 * MiB;
constexpr size_t OFF_SM = OFF_YC + 32 * MiB;
constexpr size_t OFF_PART = OFF_SM + 1 * MiB;
constexpr size_t OFF_HDN = OFF_PART + 2 * MiB;
constexpr size_t WS_NEED = OFF_HDN + 1 * MiB;
constexpr int LDS_BYTES = 144 * 1024;
#ifndef REP
#define REP 0
#endif
#define RP(bit) for (int rp_ = 0; rp_ < (((REP >> (bit)) & 1) ? 2 : 1); ++rp_)

struct Params { const float* in[37]; float* out; unsigned char* ws; };

__device__ __forceinline__ int tid_opaque() { int t = threadIdx.x; asm volatile("" : "+v"(t)); return t; }
#define TIDX tid_opaque()
__device__ __forceinline__ u32x4 zero4() { unsigned z = 0; asm volatile("" : "+v"(z)); return (u32x4){z, z, z, z}; }
extern __shared__ __attribute__((aligned(16))) unsigned char g_smem[];
constexpr int PTR_OFF = LDS_BYTES - 512;
__device__ __forceinline__ const void* ldp(int i) {
    const unsigned long long v = *(const volatile unsigned long long*)(g_smem + PTR_OFF + 8 * i);
    const unsigned lo = __builtin_amdgcn_readfirstlane((unsigned)v), hi = __builtin_amdgcn_readfirstlane((unsigned)(v >> 32));
    return (const void*)(const __attribute__((address_space(1))) void*)(((unsigned long long)hi << 32) | lo);
}
__device__ __forceinline__ bf16_t f2bf(float f) { unsigned u = __float_as_uint(f); u += 0x7FFFu + ((u >> 16) & 1u); return (bf16_t)(u >> 16); }
__device__ __forceinline__ float bf2f(bf16_t b) { return __uint_as_float(((unsigned)b) << 16); }
typedef float f32x2_t __attribute__((ext_vector_type(2)));
typedef __bf16 bf16x2_t __attribute__((ext_vector_type(2)));
__device__ __forceinline__ unsigned cvt_pk_bf16(float lo, float hi) { const f32x2_t v = {lo, hi}; const bf16x2_t b = __builtin_convertvector(v, bf16x2_t); return __builtin_bit_cast(unsigned, b); }
__device__ __forceinline__ float lo_bf(unsigned w) { return __uint_as_float(w << 16); }
__device__ __forceinline__ float hi_bf(unsigned w) { return __uint_as_float(w & 0xffff0000u); }
__device__ __forceinline__ float sigmoidf_(float x) { return __builtin_amdgcn_rcpf(1.0f + __builtin_amdgcn_exp2f(-1.4426950408889634f * x)); }
__device__ __forceinline__ float sin_acc(float x, double shift) {
    double xd = (double)x + shift; const double k = rint(xd * 0.15915494309189535); double r = xd - k * 6.283185307179586;
    const double r2 = r * r; double s = -1.0 / 51090942171709440000.0;
    s = s * r2 + 1.0 / 121645100408832000.0; s = s * r2 - 1.0 / 355687428096000.0; s = s * r2 + 1.0 / 1307674368000.0; s = s * r2 - 1.0 / 6227020800.0;
    s = s * r2 + 1.0 / 39916800.0; s = s * r2 - 1.0 / 362880.0; s = s * r2 + 1.0 / 5040.0; s = s * r2 - 1.0 / 120.0; s = s * r2 + 1.0 / 6.0;
    return (float)(r - r * r2 * s);
}

namespace pg8 {
constexpr int BM = 256, BK = 64, HALF = 128, HTB = HALF * BK * 2, STAGE_BYTES = 8 * HTB, NXCD = 8, WGM = 8;
__host__ __device__ __forceinline__ int lds_byte(int r, int c) { const int st = (r >> 4) * 2 + (c >> 5), rr = r & 15, cc = c & 31, ob = rr * 64 + cc * 2; return st * 1024 + (ob ^ (((ob >> 9) & 1) << 5)); }
__host__ __device__ __forceinline__ void stage_rc(int b, int& R, int& C) { const int st = b / 1024, sb = b % 1024, swz = sb ^ (((sb >> 9) & 1) << 5); R = (st >> 1) * 16 + swz / 64; C = (st & 1) * 32 + (swz % 64) / 2; }
__host__ __device__ __forceinline__ int perm32(int rho) { const int n = rho >> 4, i = rho & 15; return 8 * (i >> 2) + 4 * n + (i & 3); }
struct Unit { int pm, pn; };
struct Gemm { const bf16_t* A; const bf16_t* Bt; int M, N, K; };
struct StaticOrder {
    int nM, nN, nwg, G, c;
    __device__ void init(int M, int N, int G_, int c_) { nM = M / BM; nN = N / BM; nwg = nM * nN; G = G_; c = c_; }
    __device__ bool next(int i, Unit& u) const {
        const long L = (long)i * G + c; if (L >= nwg) return false;
        int wgid = (int)L; { const int q = nwg / NXCD, r = nwg % NXCD, xcd = wgid % NXCD, off = wgid / NXCD; wgid = (xcd < r ? xcd * (q + 1) : r * (q + 1) + (xcd - r) * q) + off; }
        const int nig = WGM * nN, gid = wgid / nig, fm = gid * WGM, gsz = (nM - fm) < WGM ? (nM - fm) : WGM;
        u.pm = fm + ((wgid % nig) % gsz); u.pn = (wgid % nig) / gsz; return true;
    }
};

template <class Epi>
__device__ __forceinline__ void gemm_phase(LAS unsigned char* lds, const Gemm g, const StaticOrder& S, const Epi& E, const bool perm) {
    const int tid = TIDX, wid = __builtin_amdgcn_readfirstlane(tid >> 6), lane = tid & 63, wr = wid >> 2, wc = wid & 3, fr = lane & 15, fq = lane >> 4;
    const int K = g.K, nt = K / BK;
    unsigned voffA[2], voffB[2];
#pragma unroll
    for (int i = 0; i < 2; ++i) { int R, C; stage_rc(tid * 16 + i * 8192, R, C); const int Rb = perm ? ((R & ~31) + perm32(R & 31)) : R;
        voffA[i] = (unsigned)(R * K + C) * 2u; voffB[i] = (unsigned)(Rb * K + C) * 2u; }
    const size_t kstep = (size_t)(BK * 2);
    const size_t hstep = (size_t)HALF * K * 2;
    const size_t tstep = 2 * hstep;
    const unsigned ldsw = (unsigned)wid * 1024u;
    const int aoff = lds_byte(wr * 64 + fr, fq * 8), boff = lds_byte(wc * 32 + fr, fq * 8);
#define PG8_SA(b, h) (((b) * 2 + (h)) * HTB)
#define PG8_SB(b, h) ((4 + (b) * 2 + (h)) * HTB)
#define PG8_STAGE(bufoff, gbase, voff) do { _Pragma("unroll") for (int _i = 0; _i < 2; ++_i) \
        __builtin_amdgcn_global_load_lds((const unsigned*)((const char*)(gbase) + (voff)[_i]), (LAS unsigned*)(lds + (bufoff) + ldsw + _i * 8192), 16, 0, 0); } while (0)
#define PG8_LDA(dst, b, h) do { _Pragma("unroll") for (int m = 0; m < 4; ++m) _Pragma("unroll") for (int k = 0; k < 2; ++k) dst[m][k] = *(const LAS bf16x8*)(lds + PG8_SA(b, h) + aoff + m * 2048 + k * 1024); } while (0)
#define PG8_LDB(dst, b, h) do { _Pragma("unroll") for (int n = 0; n < 2; ++n) _Pragma("unroll") for (int k = 0; k < 2; ++k) dst[n][k] = *(const LAS bf16x8*)(lds + PG8_SB(b, h) + boff + n * 2048 + k * 1024); } while (0)
#define PG8_MMA(ai, bj, At, Bt) do { __builtin_amdgcn_s_setprio(1); _Pragma("unroll") for (int m = 0; m < 4; ++m) _Pragma("unroll") for (int n = 0; n < 2; ++n) _Pragma("unroll") for (int k = 0; k < 2; ++k) \
        acc[ai][bj][m][n] = __builtin_amdgcn_mfma_f32_16x16x32_bf16(Bt[n][k], At[m][k], acc[ai][bj][m][n], 0, 0, 0); __builtin_amdgcn_s_setprio(0); } while (0)
#define PG8_WAIT_V(n) asm volatile("s_waitcnt vmcnt(" #n ")" ::: "memory")
#define PG8_WAIT_L(n) asm volatile("s_waitcnt lgkmcnt(" #n ")" ::: "memory")
#define PG8_BAR __builtin_amdgcn_s_barrier()
#define PG8_SCHED __builtin_amdgcn_sched_barrier(0)
    Unit cur, nxt; int ui = 0;
    if (!S.next(0, cur)) return;
    f32x4 acc[2][2][4][2];
#pragma unroll
    for (int a = 0; a < 2; ++a)
#pragma unroll
        for (int b = 0; b < 2; ++b)
#pragma unroll
            for (int m = 0; m < 4; ++m)
#pragma unroll
                for (int n = 0; n < 2; ++n) acc[a][b][m][n] = (f32x4){0.f, 0.f, 0.f, 0.f};
    bf16x8 At[4][2], B0[2][2], B1[2][2];
    const char* cA = (const char*)g.A + (size_t)cur.pm * tstep; const char* cB = (const char*)g.Bt + (size_t)cur.pn * tstep;
    PG8_STAGE(PG8_SB(0, 0), cB, voffB); PG8_STAGE(PG8_SA(0, 0), cA, voffA); PG8_STAGE(PG8_SB(0, 1), cB + hstep, voffB); PG8_STAGE(PG8_SA(0, 1), cA + hstep, voffA);
    if (wr == 1) PG8_BAR;
    PG8_WAIT_V(4); PG8_BAR;
    PG8_STAGE(PG8_SB(1, 0), cB + kstep, voffB); PG8_STAGE(PG8_SA(1, 0), cA + kstep, voffA); PG8_STAGE(PG8_SB(1, 1), cB + hstep + kstep, voffB);
    PG8_WAIT_V(6); PG8_BAR;
    for (;;) {
        const bool has_next = S.next(ui + 1, nxt);
        const char* nA = has_next ? (const char*)g.A + (size_t)nxt.pm * tstep : cA; const char* nB = has_next ? (const char*)g.Bt + (size_t)nxt.pn * tstep : cB;
        for (int t = 0; t < nt; t += 2) {
            if (E.hook() && (t == 8 || t == 16)) E.rescale(acc, cur, t >> 4, wr, wc, fr, fq);
            const bool last = (t == nt - 2);
            const char* a1 = cA + (size_t)(t + 1) * kstep;
            const char* a2 = last ? nA : cA + (size_t)(t + 2) * kstep; const char* b2 = last ? nB : cB + (size_t)(t + 2) * kstep;
            const char* a3 = a2 + kstep; const char* b3 = b2 + kstep;
            PG8_LDB(B0, 0, 0); PG8_SCHED; PG8_LDA(At, 0, 0); PG8_STAGE(PG8_SA(1, 1), a1 + hstep, voffA);
            PG8_WAIT_L(8); PG8_BAR; PG8_WAIT_L(0); PG8_MMA(0, 0, At, B0); PG8_BAR; PG8_SCHED;
            PG8_LDB(B1, 0, 1); PG8_STAGE(PG8_SB(0, 0), b2, voffB);
            PG8_BAR; PG8_WAIT_L(0); PG8_MMA(0, 1, At, B1); PG8_BAR;
            PG8_LDA(At, 0, 1); PG8_STAGE(PG8_SA(0, 0), a2, voffA);
            PG8_BAR; PG8_WAIT_L(0); PG8_MMA(1, 0, At, B0); PG8_BAR; PG8_SCHED;
            PG8_STAGE(PG8_SB(0, 1), b2 + hstep, voffB);
            PG8_WAIT_V(6); PG8_BAR; PG8_MMA(1, 1, At, B1); PG8_BAR;
            PG8_LDB(B0, 1, 0); PG8_SCHED; PG8_LDA(At, 1, 0); PG8_STAGE(PG8_SA(0, 1), a2 + hstep, voffA);
            PG8_WAIT_L(8); PG8_BAR; PG8_WAIT_L(0); PG8_MMA(0, 0, At, B0); PG8_BAR; PG8_SCHED;
            PG8_LDB(B1, 1, 1); PG8_STAGE(PG8_SB(1, 0), b3, voffB);
            PG8_BAR; PG8_WAIT_L(0); PG8_MMA(0, 1, At, B1); PG8_BAR;
            PG8_LDA(At, 1, 1); PG8_STAGE(PG8_SA(1, 0), a3, voffA);
            PG8_BAR; PG8_WAIT_L(0); PG8_MMA(1, 0, At, B0); PG8_BAR; PG8_SCHED;
            PG8_STAGE(PG8_SB(1, 1), b3 + hstep, voffB);
            PG8_WAIT_V(6); PG8_BAR; PG8_MMA(1, 1, At, B1); PG8_BAR;
        }
        E(acc, cur, ui, wr, wc, fr, fq);
        if (!has_next) break;
#pragma unroll
        for (int a = 0; a < 2; ++a)
#pragma unroll
            for (int b = 0; b < 2; ++b)
#pragma unroll
                for (int m = 0; m < 4; ++m)
#pragma unroll
                    for (int n = 0; n < 2; ++n) acc[a][b][m][n] = (f32x4){0.f, 0.f, 0.f, 0.f};
        cur = nxt; cA = nA; cB = nB; ++ui;
    }
    PG8_WAIT_V(0);
    if (wr == 0) PG8_BAR;
    PG8_BAR;
#undef PG8_SA
#undef PG8_SB
#undef PG8_STAGE
#undef PG8_LDA
#undef PG8_LDB
#undef PG8_MMA
#undef PG8_WAIT_V
#undef PG8_WAIT_L
#undef PG8_BAR
#undef PG8_SCHED
}
}
using pg8::Unit; using pg8::HALF; using pg8::BM;
typedef const f32x4 (&AccRef)[2][2][4][2];

constexpr int RT_OFF = 128 * 1024;
__device__ __forceinline__ void row_scales(const LAS float* rt, int lrow0, float (&rr)[2][4]) {
#pragma unroll
    for (int ai = 0; ai < 2; ++ai)
#pragma unroll
        for (int m = 0; m < 4; ++m) rr[ai][m] = rt[lrow0 + ai * HALF + m * 16];
}
struct EpiSwiGLU {
    static constexpr bool PERM = false;
    bf16_t* act; const LAS float* part;
    __device__ __forceinline__ void operator()(AccRef acc, const Unit& u, int wr, int wc, int fr, int fq) const {
        const int row0 = u.pm * BM + wr * 64 + fr;
        float rr[2][4]; row_scales(part, wr * 64 + fr, rr);
#pragma unroll
        for (int ai = 0; ai < 2; ++ai)
#pragma unroll
            for (int m = 0; m < 4; ++m) { bf16_t* rowp = act + (size_t)(row0 + ai * HALF + m * 16) * DFF; const float rs = rr[ai][m];
#pragma unroll
                for (int bj = 0; bj < 2; ++bj) { const int ac = (u.pn * BM + bj * HALF + wc * 32) / 2 + 4 * fq;
                    const f32x4 gg = acc[ai][bj][m][0], uu = acc[ai][bj][m][1]; float o[4]; const float rs2 = rs * rs, nrs = -1.4426950408889634f * rs;
#pragma unroll
                    for (int i = 0; i < 4; ++i) o[i] = (rs2 * gg[i]) * uu[i] * __builtin_amdgcn_rcpf(1.0f + __builtin_amdgcn_exp2f(nrs * gg[i]));
                    u32x2 w; w.x = cvt_pk_bf16(o[0], o[1]); w.y = cvt_pk_bf16(o[2], o[3]); *(u32x2*)(rowp + ac) = w; } }
    }
};
struct EpiResid {
    static constexpr bool PERM = true;
    float* h; float scale; bf16_t* hb; float* part;
    __device__ __forceinline__ void operator()(AccRef acc, const Unit& u, int wr, int wc, int fr, int fq) const {
        const int row0 = u.pm * BM + wr * 64 + fr, col0 = u.pn * BM + wc * 32 + 8 * fq;
#pragma unroll
        for (int ai = 0; ai < 2; ++ai)
#pragma unroll
          for (int mp = 0; mp < 2; ++mp) {
            f32x4 hv[2][2][2];
#pragma unroll
            for (int mm = 0; mm < 2; ++mm) { const float* rowp = h + (size_t)(row0 + ai * HALF + (mp * 2 + mm) * 16) * DM + col0;
#pragma unroll
                for (int bj = 0; bj < 2; ++bj) { hv[mm][bj][0] = *(const f32x4*)(rowp + bj * HALF); hv[mm][bj][1] = *(const f32x4*)(rowp + bj * HALF + 4); } }
#pragma unroll
            for (int mm = 0; mm < 2; ++mm) { const int m = mp * 2 + mm; const size_t row = (size_t)(row0 + ai * HALF + m * 16); float* rowp = h + row * DM + col0; bf16_t* rowb = hb + row * DM + col0; float ss = 0.f;
#pragma unroll
                for (int bj = 0; bj < 2; ++bj) { const f32x4 a = hv[mm][bj][0] + acc[ai][bj][m][0] * scale, b = hv[mm][bj][1] + acc[ai][bj][m][1] * scale;
                    __builtin_nontemporal_store(a, (f32x4*)(rowp + bj * HALF)); __builtin_nontemporal_store(b, (f32x4*)(rowp + bj * HALF + 4));
                    ss += (a[0] * a[0] + a[1] * a[1]) + (a[2] * a[2] + a[3] * a[3]) + (b[0] * b[0] + b[1] * b[1]) + (b[2] * b[2] + b[3] * b[3]);
                    u32x4 w; w.x = cvt_pk_bf16(a[0], a[1]); w.y = cvt_pk_bf16(a[2], a[3]); w.z = cvt_pk_bf16(b[0], b[1]); w.w = cvt_pk_bf16(b[2], b[3]);
                    *(u32x4*)(rowb + bj * HALF) = w; }
                ss += __shfl_xor(ss, 16); ss += __shfl_xor(ss, 32);
                if (fq == 0) part[row * 16 + u.pn * 4 + wc] = ss; } }
    }
};
struct EpiBf16Split {
    static constexpr bool PERM = true;
    bf16_t* O0; int ld0; bf16_t* O1; int ld1; int split; const LAS float* part;
    __device__ __forceinline__ void operator()(AccRef acc, const Unit& u, int wr, int wc, int fr, int fq) const {
        const int row0 = u.pm * BM + wr * 64 + fr; int colt = u.pn * BM; bf16_t* base = O0; int ld = ld0;
        float rr[2][4]; row_scales(part, wr * 64 + fr, rr);
        if (colt >= split) { base = O1; ld = ld1; colt -= split; }
        const int col0 = colt + wc * 32 + 8 * fq;
#pragma unroll
        for (int ai = 0; ai < 2; ++ai)
#pragma unroll
            for (int m = 0; m < 4; ++m) { bf16_t* rowp = base + (size_t)(row0 + ai * HALF + m * 16) * ld + col0;
#pragma unroll
                for (int bj = 0; bj < 2; ++bj) { const f32x4 v0 = acc[ai][bj][m][0] * rr[ai][m], v1 = acc[ai][bj][m][1] * rr[ai][m];
                    u32x4 w; w.x = cvt_pk_bf16(v0[0], v0[1]); w.y = cvt_pk_bf16(v0[2], v0[3]); w.z = cvt_pk_bf16(v1[0], v1[1]); w.w = cvt_pk_bf16(v1[2], v1[3]);
                    *(u32x4*)(rowp + bj * HALF) = w; } }
    }
};
struct EpiGate {
    static constexpr bool PERM = true;
    bf16_t* O; const float* bias; const LAS float* part;
    __device__ __forceinline__ void operator()(AccRef acc, const Unit& u, int wr, int wc, int fr, int fq) const {
        const int row0 = u.pm * BM + wr * 64 + fr, col0 = u.pn * BM + wc * 32 + 8 * fq;
        float rr[2][4]; row_scales(part, wr * 64 + fr, rr);
#pragma unroll
        for (int bj = 0; bj < 2; ++bj) { const f32x4 b0 = *(const f32x4*)(bias + col0 + bj * HALF), b1 = *(const f32x4*)(bias + col0 + bj * HALF + 4);
#pragma unroll
            for (int ai = 0; ai < 2; ++ai)
#pragma unroll
                for (int m = 0; m < 4; ++m) { bf16_t* rowp = O + (size_t)(row0 + ai * HALF + m * 16) * 3072 + col0 + bj * HALF;
                    const f32x4 v0 = acc[ai][bj][m][0] * rr[ai][m] + b0, v1 = acc[ai][bj][m][1] * rr[ai][m] + b1;
                    u32x4 w; w.x = cvt_pk_bf16(sigmoidf_(v0[0]), sigmoidf_(v0[1])); w.y = cvt_pk_bf16(sigmoidf_(v0[2]), sigmoidf_(v0[3]));
                    w.z = cvt_pk_bf16(sigmoidf_(v1[0]), sigmoidf_(v1[1])); w.w = cvt_pk_bf16(sigmoidf_(v1[2]), sigmoidf_(v1[3]));
                    *(u32x4*)rowp = w; } }
    }
};
struct EpiBranchCat {
    static constexpr bool PERM = true;
    const bf16_t* gates; bf16_t* mb;
    typedef f32x4 (&AccMut)[2][2][4][2];
    __device__ __forceinline__ void rescale(AccMut acc, const Unit& u, int which, int wr, int wc, int fr, int fq) const {
        int row0 = u.pm * BM + wr * 64 + fr, col0 = u.pn * BM + wc * 32 + 8 * fq;
        asm volatile("" : "+v"(row0), "+v"(col0));
#pragma unroll
        for (int ai = 0; ai < 2; ++ai) {
            u32x4 gav[4][2], gbv[4][2];
#pragma unroll
            for (int m = 0; m < 4; ++m)
#pragma unroll
                for (int bj = 0; bj < 2; ++bj) { const bf16_t* gp = gates + (size_t)(row0 + ai * HALF + m * 16) * 3072 + which * 1024 + col0 + bj * HALF; gav[m][bj] = *(const u32x4*)gp; gbv[m][bj] = *(const u32x4*)(gp + 1024); }
#pragma unroll
            for (int m = 0; m < 4; ++m)
#pragma unroll
                for (int bj = 0; bj < 2; ++bj) { const u32x4 ga = gav[m][bj], gb = gbv[m][bj];
                    acc[ai][bj][m][0][0] *= lo_bf(ga.x) * __builtin_amdgcn_rcpf(lo_bf(gb.x)); acc[ai][bj][m][0][1] *= hi_bf(ga.x) * __builtin_amdgcn_rcpf(hi_bf(gb.x)); acc[ai][bj][m][0][2] *= lo_bf(ga.y) * __builtin_amdgcn_rcpf(lo_bf(gb.y)); acc[ai][bj][m][0][3] *= hi_bf(ga.y) * __builtin_amdgcn_rcpf(hi_bf(gb.y));
                    acc[ai][bj][m][1][0] *= lo_bf(ga.z) * __builtin_amdgcn_rcpf(lo_bf(gb.z)); acc[ai][bj][m][1][1] *= hi_bf(ga.z) * __builtin_amdgcn_rcpf(hi_bf(gb.z)); acc[ai][bj][m][1][2] *= lo_bf(ga.w) * __builtin_amdgcn_rcpf(lo_bf(gb.w)); acc[ai][bj][m][1][3] *= hi_bf(ga.w) * __builtin_amdgcn_rcpf(hi_bf(gb.w)); }
            __builtin_amdgcn_sched_barrier(0); }
    }
    __device__ __forceinline__ void operator()(AccRef acc, const Unit& u, int wr, int wc, int fr, int fq) const {
        const int row0 = u.pm * BM + wr * 64 + fr, col0 = u.pn * BM + wc * 32 + 8 * fq;
#pragma unroll
        for (int ai = 0; ai < 2; ++ai) {
            u32x4 gwv[4][2];
#pragma unroll
            for (int m = 0; m < 4; ++m)
#pragma unroll
                for (int bj = 0; bj < 2; ++bj) gwv[m][bj] = *(const u32x4*)(gates + (size_t)(row0 + ai * HALF + m * 16) * 3072 + 2048 + col0 + bj * HALF);
#pragma unroll
            for (int m = 0; m < 4; ++m) { const size_t row = (size_t)(row0 + ai * HALF + m * 16);
#pragma unroll
                for (int bj = 0; bj < 2; ++bj) { const int col = col0 + bj * HALF;
                    const u32x4 gw = gwv[m][bj];
                    const f32x4 v0 = acc[ai][bj][m][0], v1 = acc[ai][bj][m][1];
                    u32x4 w; w.x = cvt_pk_bf16(v0[0] * lo_bf(gw.x), v0[1] * hi_bf(gw.x)); w.y = cvt_pk_bf16(v0[2] * lo_bf(gw.y), v0[3] * hi_bf(gw.y));
                    w.z = cvt_pk_bf16(v1[0] * lo_bf(gw.z), v1[1] * hi_bf(gw.z)); w.w = cvt_pk_bf16(v1[2] * lo_bf(gw.w), v1[3] * hi_bf(gw.w));
                    *(u32x4*)(mb + row * DM + col) = w; } } }
    }
};
struct EpiRG {
    static constexpr bool PERM = false;
    const bf16_t* xc; bf16_t* loga; bf16_t* uu;
    const float* ba; const float* bx; const float* lam;
    __device__ __forceinline__ void operator()(AccRef acc, const Unit& u, int wr, int wc, int fr, int fq) const {
        const int row0 = u.pm * BM + wr * 64 + fr;
#pragma unroll
        for (int bj = 0; bj < 2; ++bj) { const int c = u.pn * BM + bj * HALF + wc * 32; const int dir = c >> 10; const int ch = ((c & 1023) >> 1) + 4 * fq;
            const f32x4 vba = *(const f32x4*)(ba + dir * 512 + ch), vbx = *(const f32x4*)(bx + dir * 512 + ch), vl = *(const f32x4*)(lam + dir * 512 + ch);
            const f32x4 cc = vl;
#pragma unroll
            for (int ai = 0; ai < 2; ++ai) {
                u32x2 xwv[4];
#pragma unroll
                for (int m = 0; m < 4; ++m) xwv[m] = *(const u32x2*)(xc + (size_t)(row0 + ai * HALF + m * 16) * 512 + ch);
#pragma unroll
                for (int m = 0; m < 4; ++m) { const size_t row = (size_t)(row0 + ai * HALF + m * 16);
                    const u32x2 xw = xwv[m];
                    const float xv[4] = {lo_bf(xw.x), hi_bf(xw.x), lo_bf(xw.y), hi_bf(xw.y)};
                    float la[4], uo[4];
#pragma unroll
                    for (int i = 0; i < 4; ++i) { const float r = sigmoidf_(acc[ai][bj][m][0][i] + vba[i]), gi = sigmoidf_(acc[ai][bj][m][1][i] + vbx[i]);
                        const float l = cc[i] * r; la[i] = l; const float x2 = 2.0f * l;
                        const float em1 = (x2 > -0.25f) ? x2 * (1.0f + x2 * (0.5f + x2 * (1.0f / 6.0f + x2 * (1.0f / 24.0f + x2 * (1.0f / 120.0f + x2 * (1.0f / 720.0f)))))) : (__expf(x2) - 1.0f);
                        uo[i] = __builtin_amdgcn_sqrtf(fmaxf(-em1, 0.0f)) * gi * xv[i]; }
                    u32x2 w0, w1; w0.x = cvt_pk_bf16(la[0], la[1]); w0.y = cvt_pk_bf16(la[2], la[3]); w1.x = cvt_pk_bf16(uo[0], uo[1]); w1.y = cvt_pk_bf16(uo[2], uo[3]);
                    *(u32x2*)(loga + ((size_t)dir * MT + row) * 512 + ch) = w0; *(u32x2*)(uu + ((size_t)dir * MT + row) * 512 + ch) = w1; } } }
    }
};

struct GDesc { const bf16_t* A; const bf16_t* Bt; int M, N, K, kind; void* p0; void* p1; const void* q0; const void* q1; const void* q2; const void* q3; int i0, i1, i2; float f0; };
struct EpiAny {
    GDesc d;
    __device__ __forceinline__ bool hook() const { return d.kind == 4; }
    __device__ __forceinline__ void rescale(f32x4 (&acc)[2][2][4][2], const Unit& u, int which, int wr, int wc, int fr, int fq) const { EpiBranchCat e; e.gates = (const bf16_t*)d.q0; e.mb = nullptr; e.rescale(acc, u, which, wr, wc, fr, fq); }
    __device__ __forceinline__ void operator()(AccRef acc, const Unit& u, int ui, int wr, int wc, int fr, int fq) const {
        const LAS float* rt = (const LAS float*)((LAS unsigned char*)g_smem + RT_OFF) + ui * 256;
        switch (d.kind) {
        case 0: { EpiSwiGLU e; e.act = (bf16_t*)d.p0; e.part = rt; e(acc, u, wr, wc, fr, fq); } break;
        case 1: { EpiResid e; e.h = (float*)d.p0; e.scale = d.f0; e.hb = (bf16_t*)d.p1; e.part = (float*)d.q3; e(acc, u, wr, wc, fr, fq); } break;
        case 2: { EpiBf16Split e; e.O0 = (bf16_t*)d.p0; e.ld0 = d.i0; e.O1 = (bf16_t*)d.p1; e.ld1 = d.i1; e.split = d.i2; e.part = rt; e(acc, u, wr, wc, fr, fq); } break;
        case 3: { EpiGate e; e.O = (bf16_t*)d.p0; e.bias = (const float*)d.q0; e.part = rt; e(acc, u, wr, wc, fr, fq); } break;
        case 4: { EpiBranchCat e; e.gates = (const bf16_t*)d.q0; e.mb = (bf16_t*)d.p1; e(acc, u, wr, wc, fr, fq); } break;
        default: { EpiRG e; e.xc = (const bf16_t*)d.q0; e.loga = (bf16_t*)d.p0; e.uu = (bf16_t*)d.p1; e.ba = (const float*)d.q1; e.bx = (const float*)d.q2; e.lam = (const float*)d.q3; e(acc, u, wr, wc, fr, fq); } break;
        }
    }
};
__device__ __forceinline__ void run_gemm(unsigned char* smem, const GDesc& d) {
    pg8::Gemm g; g.A = d.A; g.Bt = d.Bt; g.M = d.M; g.N = d.N; g.K = d.K;
    pg8::StaticOrder S; S.init(d.M, d.N, (int)gridDim.x, (int)blockIdx.x);
    EpiAny E; E.d = d;
    if (d.kind == 0 || d.kind == 2 || d.kind == 3) {
        const float* part = (const float*)d.q3; float* rtab = (float*)(smem + RT_OFF); int* pmtab = (int*)(smem + RT_OFF + 12 * 1024); const int tid = TIDX;
        if (tid < 16) { pg8::Unit u; pmtab[tid] = S.next(tid, u) ? u.pm : -1; }
        __syncthreads();
#pragma unroll
        for (int k = 0; k < 6; ++k) { const int idx = tid + 512 * k, i = idx >> 8, row = idx & 255; const int pm = (i < 12) ? pmtab[i] : -1;
            if (pm >= 0) { const f32x4* pp = (const f32x4*)(part + (size_t)(pm * BM + row) * 16); const f32x4 a = pp[0], b = pp[1], c = pp[2], e4 = pp[3];
                const float ss = ((a[0] + a[1]) + (a[2] + a[3])) + ((b[0] + b[1]) + (b[2] + b[3])) + ((c[0] + c[1]) + (c[2] + c[3])) + ((e4[0] + e4[1]) + (e4[2] + e4[3]));
                rtab[idx] = 1.0f / sqrtf(ss * (1.0f / DM) + 1e-6f); } }
        __syncthreads();
    }
    pg8::gemm_phase<EpiAny>((LAS unsigned char*)smem, g, S, E, !(d.kind == 0 || d.kind == 7));
    __syncthreads();
}

template <class F>
__device__ __forceinline__ void conv_tiles(float* tile, bf16_t* Bt, int R, int K, int rot, F src, int ld = 0) {
    if (ld == 0) ld = K;
    const int tid = TIDX, lane = tid & 63, w = tid >> 6;
    const int nkt = K / 64, ntile = (R / 64) * nkt;
    const int first = ((int)blockIdx.x + rot) % (int)gridDim.x;
    for (int t_ = first; t_ < ntile * ((REP & 1) + 1); t_ += gridDim.x) { const int t = t_ % ntile;
        const int r0 = (t / nkt) * 64, k0 = (t % nkt) * 64;
        __syncthreads();
#pragma unroll
        for (int i = 0; i < 8; ++i) { const int kk = i * 8 + w; tile[kk * 65 + lane] = src(k0 + kk, r0 + lane); }
        __syncthreads();
#pragma unroll
        for (int i = 0; i < 8; ++i) { const int j = i * 8 + w; Bt[(size_t)(r0 + j) * ld + k0 + lane] = f2bf(tile[lane * 65 + j]); }
    }
}

__device__ void convert_phase(unsigned char* smem, const Params& p, int l) {
    float* tile = (float*)smem; bf16_t* wt = (bf16_t*)(((unsigned char*)ldp(38)) + OFF_WT);
    const size_t uo = (size_t)l * DM * DFF;
    { const float* wg = ((const float*)ldp(2)) + uo; const float* wu = ((const float*)ldp(3)) + uo; const float* gn = ((const float*)ldp(1)) + l * DM;
      conv_tiles(tile, wt + W_UP1, 5632, 1024, 0, [=](int k, int r) { const int col = (r >> 5) * 16 + (r & 15); return gn[k] * (((r >> 4) & 1) ? wu[(size_t)k * DFF + col] : wg[(size_t)k * DFF + col]); }); }
    { const float* wd = ((const float*)ldp(4)) + uo; conv_tiles(tile, wt + W_DN1, 1024, 2816, 37, [=](int k, int r) { return wd[(size_t)k * DM + r]; }); }
    { const float* wi = ((const float*)ldp(6)) + (size_t)l * DM * INC; const float* gn = ((const float*)ldp(5)) + l * DM;
      conv_tiles(tile, wt + W_HYRG, 2560, 1024, 71, [=](int k, int r) { const int col = r < HYC ? r : r + QKVC; return gn[k] * wi[(size_t)k * INC + col]; });
      conv_tiles(tile, wt + W_QKV, 4608, 1024, 113, [=](int k, int r) { return gn[k] * wi[(size_t)k * INC + HYC + r]; }); }
    { const float* wgt = ((const float*)ldp(26)) + (size_t)l * DM * 3072; const float* gn = ((const float*)ldp(5)) + l * DM; conv_tiles(tile, wt + W_GATE, 3072, 1024, 151, [=](int k, int r) { return gn[k] * wgt[(size_t)k * 3072 + r]; }); }
    { const float* a = ((const float*)ldp(28)) + (size_t)l * 512 * DM; conv_tiles(tile, wt + W_PCAT + 0, 1024, 512, 193, [=](int k, int r) { return a[(size_t)k * DM + r]; }, 1536); }
    { const float* a = ((const float*)ldp(29)) + (size_t)l * 512 * DM; conv_tiles(tile, wt + W_PCAT + 512, 1024, 512, 211, [=](int k, int r) { return a[(size_t)k * DM + r]; }, 1536); }
    { const float* a = ((const float*)ldp(30)) + (size_t)l * 512 * DM; conv_tiles(tile, wt + W_PCAT + 1024, 1024, 512, 229, [=](int k, int r) { return a[(size_t)k * DM + r]; }, 1536); }
    { const float* a = ((const float*)ldp(31)) + (size_t)l * DM * DM; conv_tiles(tile, wt + W_OUT, 1024, 1024, 17, [=](int k, int r) { return a[(size_t)k * DM + r]; }); }
    { const float* wg = ((const float*)ldp(33)) + uo; const float* wu = ((const float*)ldp(34)) + uo; const float* gn = ((const float*)ldp(32)) + l * DM;
      conv_tiles(tile, wt + W_UP2, 5632, 1024, 53, [=](int k, int r) { const int col = (r >> 5) * 16 + (r & 15); return gn[k] * (((r >> 4) & 1) ? wu[(size_t)k * DFF + col] : wg[(size_t)k * DFF + col]); }); }
    { const float* wd = ((const float*)ldp(35)) + uo; conv_tiles(tile, wt + W_DN2, 1024, 2816, 97, [=](int k, int r) { return wd[(size_t)k * DM + r]; }); }
    { const float* wa = ((const float*)ldp(21)) + (size_t)l * 2 * 8 * 64 * 64; const float* wx = ((const float*)ldp(23)) + (size_t)l * 2 * 8 * 64 * 64;
      conv_tiles(tile, wt + W_RG, 2048, 512, 131, [=](int k, int r) { const int dir = r >> 10, cp = r & 1023, ch = (cp >> 5) * 16 + (cp & 15), hb = ch >> 6, jj = ch & 63;
          if ((k >> 6) != hb) return 0.0f; const float* src = ((cp >> 4) & 1) ? wx : wa; return src[(((size_t)dir * 8 + hb) * 64 + (k & 63)) * 64 + jj]; }); }
    float* sm = (float*)(((unsigned char*)ldp(38)) + OFF_SM);
    if (blockIdx.x == 0) { for (int i = TIDX; i < 1024; i += 512) sm[i] = 0.0f; }
    if (blockIdx.x == 2 % gridDim.x) { const float* lam = ((const float*)ldp(25)) + l * 1024; for (int i = TIDX; i < 1024; i += 512) sm[4224 + i] = -8.0f * log1pf(expf(-lam[i])); }
    if (blockIdx.x == 1 % gridDim.x) {
        const float* rb = ((const float*)ldp(18));
        for (int i = TIDX; i < 24 * 129; i += 512) { const int hh = i / 129, delta = i % 129 - 64, d = 1 << (2 * (hh >> 3)); const int rel = delta * d;
            const int n = rel < 0 ? -rel : rel; int bucket = rel > 0 ? 16 : 0;
            if (n < 8) bucket += n; else { const float nf = (float)n; int lg = 8 + (int)(logf(nf / 8.0f) / 4.852030263919617f * 8.0f); if (lg > 15) lg = 15; bucket += lg; }
            sm[1024 + i] = rb[bucket * 24 + hh]; }
    }
}

__device__ void rmsnorm_phase(const float* src, const float* g, float* copy_dst, bf16_t* xn, float* outf) {
    const int lane = TIDX & 63, gw = blockIdx.x * 8 + (TIDX >> 6), nw = gridDim.x * 8;
    f32x4 gv[4];
#pragma unroll
    for (int j = 0; j < 4; ++j) gv[j] = ((const f32x4*)g)[lane + 64 * j];
    for (int row = gw; row < MT; row += nw) {
        const f32x4* pr = (const f32x4*)(src + (size_t)row * DM); f32x4 v[4]; float ss = 0.f;
#pragma unroll
        for (int j = 0; j < 4; ++j) { v[j] = pr[lane + 64 * j]; ss += v[j][0] * v[j][0] + v[j][1] * v[j][1] + v[j][2] * v[j][2] + v[j][3] * v[j][3]; }
#pragma unroll
        for (int o = 32; o >= 1; o >>= 1) ss += __shfl_xor(ss, o);
        const float r = 1.0f / sqrtf(ss * (1.0f / DM) + 1e-6f);
#pragma unroll
        for (int j = 0; j < 4; ++j) { const f32x4 y = v[j] * r * gv[j];
            if (copy_dst) ((f32x4*)(copy_dst + (size_t)row * DM))[lane + 64 * j] = v[j];
            if (xn) { u32x2 w; w.x = cvt_pk_bf16(y[0], y[1]); w.y = cvt_pk_bf16(y[2], y[3]); ((u32x2*)(xn + (size_t)row * DM))[lane + 64 * j] = w; }
            if (outf) ((f32x4*)(outf + (size_t)row * DM))[lane + 64 * j] = y; }
    }
}

__device__ void prep_phase(const float* x, float* h, bf16_t* hb, float* part) {
    const int tid = TIDX, lane = tid & 63, gw = blockIdx.x * 8 + (tid >> 6), nw = gridDim.x * 8;
    for (int row = gw; row < MT; row += nw) {
        const f32x4* pr = (const f32x4*)(x + (size_t)row * DM); float ss = 0.f;
#pragma unroll
        for (int j = 0; j < 4; ++j) { const f32x4 v = pr[lane + 64 * j]; ss += v[0] * v[0] + v[1] * v[1] + v[2] * v[2] + v[3] * v[3];
            ((f32x4*)(h + (size_t)row * DM))[lane + 64 * j] = v;
            u32x2 w; w.x = cvt_pk_bf16(v[0], v[1]); w.y = cvt_pk_bf16(v[2], v[3]); ((u32x2*)(hb + (size_t)row * DM))[lane + 64 * j] = w; }
#pragma unroll
        for (int o = 32; o >= 1; o >>= 1) ss += __shfl_xor(ss, o);
        if (lane < 16) part[(size_t)row * 16 + lane] = (lane == 0) ? ss : 0.f;
    }
}

__device__ void filter_mlp_phase(unsigned char* smem, int l) {
    float* zz = (float*)smem;
    float* ha = zz + 8 * 36;
    float* hb = ha + 8 * 64;
    const float* w1 = ((const float*)ldp(9)) + (size_t)l * 33 * 64; const float* b1 = ((const float*)ldp(10)) + l * 64; const float* w2 = ((const float*)ldp(11)) + (size_t)l * 64 * 64; const float* b2 = ((const float*)ldp(12)) + l * 64;
    const float* w3 = ((const float*)ldp(13)) + (size_t)l * 64 * 64; const float* b3 = ((const float*)ldp(14)) + l * 64; const float* fr = ((const float*)ldp(15)) + l * 64;
    float* hdn = (float*)(((unsigned char*)ldp(38)) + OFF_HDN);
    const int tid = TIDX, u = tid & 63, ps = tid >> 6;
    for (int tile = blockIdx.x; tile < 256; tile += gridDim.x) {
        const int pos = tile * 8 + ps;
        __syncthreads();
        if (u < 33) { float f;
            if (u == 0) f = (float)pos / 2047.0f;
            else { const int bi = (u - 1) & 15; const float fb = 1e-4f + (float)bi * ((15.0f - 1e-4f) / 15.0f); const float wpos = 6.283185307179586f * (float)pos / 2048.0f; const float arg = fb * wpos;
                f = (u <= 16) ? sin_acc(arg, 1.5707963267948966) : -sin_acc(arg, 0.0); }
            zz[ps * 36 + u] = f; }
        __syncthreads();
        { float a = b1[u];
#pragma unroll 3
            for (int k = 0; k < 33; ++k) a += zz[ps * 36 + k] * w1[k * 64 + u]; ha[ps * 64 + u] = sin_acc(fr[u] * a, 0.0); }
        __syncthreads();
        { float a = b2[u];
#pragma unroll 4
            for (int k = 0; k < 64; ++k) a += ha[ps * 64 + k] * w2[k * 64 + u]; hb[ps * 64 + u] = sin_acc(fr[u] * a, 0.0); }
        __syncthreads();
        { float a = b3[u];
#pragma unroll 4
            for (int k = 0; k < 64; ++k) a += hb[ps * 64 + k] * w3[k * 64 + u]; hdn[pos * 64 + u] = sin_acc(fr[u] * a, 0.0); }
    }
}

__device__ void filter_phase(unsigned char* smem, const Params& p, int l) {
    float* h3 = (float*)smem;
    const float* wout = ((const float*)ldp(16)) + (size_t)l * 64 * 2048; const float* hdn = (const float*)(((unsigned char*)ldp(38)) + OFF_HDN);
    float* hraw = (float*)(((unsigned char*)ldp(38)) + OFF_A + 160 * MiB); float* norms = (float*)(((unsigned char*)ldp(38)) + OFF_SM);
    const int tid = TIDX;
    for (int tile = blockIdx.x; tile < 256; tile += gridDim.x) {
        const int cb = tile & 3, pb = tile >> 2;
        __syncthreads();
        ((f32x4*)h3)[tid] = ((const f32x4*)(hdn + (size_t)pb * 32 * 64))[tid];
        __syncthreads();
        const int c = tid, dir = cb >> 1, o = cb & 1;
        const float da = -4.605170185988091f / 0.3f, db = -4.605170185988091f / 1.5f; const float delta = fabsf(da + (float)c * ((db - da) / 511.0f));
        float asum = 0.f; float* dst = hraw + ((size_t)(dir * 2 + o) * 512 + c) * 2048 + pb * 32;
#pragma unroll 1
        for (int half = 0; half < 2; ++half) {
            float accv[16];
#pragma unroll
            for (int i = 0; i < 16; ++i) accv[i] = 0.f;
#pragma unroll 2
            for (int k = 0; k < 64; ++k) { const float wv = wout[(size_t)k * 2048 + cb * 512 + c];
#pragma unroll
                for (int i = 0; i < 16; ++i) accv[i] += h3[(half * 16 + i) * 64 + k] * wv; }
#pragma unroll
            for (int i = 0; i < 16; ++i) { const int pos = pb * 32 + half * 16 + i; const float t = (float)pos / 2047.0f; const float val = accv[i] * (expf(-t * delta) + 0.05f);
                dst[half * 16 + i] = val; if (!(dir == 1 && pos == 0)) asum += fabsf(val); }
        }
        norms[16384 + pb * 2048 + cb * 512 + c] = asum;
    }
}

__device__ void hy_transpose_phase(unsigned char* smem, const Params& p, int l) {
    float* tile = (float*)smem;
    const bf16_t* uhy = (const bf16_t*)(((unsigned char*)ldp(38)) + OFF_A); bf16_t* hyT = (bf16_t*)(((unsigned char*)ldp(38)) + OFF_B);
    const float* cw = ((const float*)ldp(7)) + (size_t)l * 3 * HYC; const float* cb = ((const float*)ldp(8)) + (size_t)l * HYC;
    const int tid = TIDX;
    const int ntile = (MT / 64) * (HYC / 64);
    for (int t = blockIdx.x; t < ntile; t += gridDim.x) {
        const int cblk = t % (HYC / 64), rblk = t / (HYC / 64); const int b = rblk >> 5, t0 = (rblk & 31) * 64, c0 = cblk * 64;
        __syncthreads();
        for (int e = tid; e < 66 * 8; e += 512) { const int rr = e >> 3, c8 = e & 7; const int tt = t0 - 1 + rr;
            u32x4 v = zero4();
            if (tt >= 0 && tt < SEQ) v = *(const u32x4*)(uhy + ((size_t)b * SEQ + tt) * HYC + c0 + c8 * 8);
            float* d = tile + rr * 65 + c8 * 8;
            d[0] = lo_bf(v.x); d[1] = hi_bf(v.x); d[2] = lo_bf(v.y); d[3] = hi_bf(v.y); d[4] = lo_bf(v.z); d[5] = hi_bf(v.z); d[6] = lo_bf(v.w); d[7] = hi_bf(v.w); }
        __syncthreads();
        { const int cc = tid >> 3, t8 = tid & 7, c = c0 + cc; const float w0 = cw[c], w1 = cw[HYC + c], w2 = cw[2 * HYC + c], bb = cb[c];
          float x[10];
#pragma unroll
          for (int i = 0; i < 10; ++i) x[i] = tile[(t8 * 8 + i) * 65 + cc];
          float o[8];
#pragma unroll
          for (int i = 0; i < 8; ++i) o[i] = w0 * x[i] + w1 * x[i + 1] + w2 * x[i + 2] + bb;
          u32x4 w; w.x = cvt_pk_bf16(o[0], o[1]); w.y = cvt_pk_bf16(o[2], o[3]); w.z = cvt_pk_bf16(o[4], o[5]); w.w = cvt_pk_bf16(o[6], o[7]);
          *(u32x4*)(hyT + ((size_t)c * NB + b) * SEQ + t0 + t8 * 8) = w; }
    }
}

__device__ void ya_transpose_phase(unsigned char* smem, int first_wg, int n_wg) {
    bf16_t* tile = (bf16_t*)smem;
    const bf16_t* yaT = (const bf16_t*)(((unsigned char*)ldp(38)) + OFF_A); bf16_t* ya = (bf16_t*)(((unsigned char*)ldp(38)) + OFF_YA);
    const int tid = TIDX;
    const int ntile = (MT / 64) * (HYW / 64);
    for (int t = (int)blockIdx.x - first_wg; t < ntile; t += n_wg) {
        const int cblk = t % (HYW / 64), rblk = t / (HYW / 64); const int b = rblk >> 5, t0 = (rblk & 31) * 64, c0 = cblk * 64;
        __syncthreads();
        { const int cc = tid >> 3, t8 = tid & 7; *(u32x4*)(tile + cc * 72 + t8 * 8) = *(const u32x4*)(yaT + ((size_t)(c0 + cc) * NB + b) * SEQ + t0 + t8 * 8); }
        __syncthreads();
        { const int tt = tid >> 3, c8 = tid & 7; unsigned short v[8];
#pragma unroll
          for (int i = 0; i < 8; ++i) v[i] = tile[(c8 * 8 + i) * 72 + tt];
          u32x4 w; w.x = (unsigned)v[0] | ((unsigned)v[1] << 16); w.y = (unsigned)v[2] | ((unsigned)v[3] << 16); w.z = (unsigned)v[4] | ((unsigned)v[5] << 16); w.w = (unsigned)v[6] | ((unsigned)v[7] << 16);
          *(u32x4*)(ya + ((size_t)b * SEQ + t0 + tt) * 1536 + c0 + c8 * 8) = w; }
    }
}

__device__ void rg_conv_phase(const Params& p, int l) {
    const bf16_t* urg = (const bf16_t*)(((unsigned char*)ldp(38)) + OFF_A + 96 * MiB); bf16_t* xc = (bf16_t*)(((unsigned char*)ldp(38)) + OFF_XC);
    const float* cw = ((const float*)ldp(19)) + (size_t)l * 4 * RGW; const float* cb = ((const float*)ldp(20)) + (size_t)l * RGW;
    const int total = (MT / 16) * 64;
    for (int idx = blockIdx.x * 512 + TIDX; idx < total; idx += gridDim.x * 512) {
        const int c8 = idx & 63, run = idx >> 6, tok0 = run * 16, t0 = tok0 & (SEQ - 1);
        float wgt[4][8], bia[8];
#pragma unroll
        for (int i = 0; i < 8; ++i) { bia[i] = cb[c8 * 8 + i];
#pragma unroll
            for (int k = 0; k < 4; ++k) wgt[k][i] = cw[k * RGW + c8 * 8 + i]; }
        u32x4 win[4];
        const bf16_t* src = urg + (size_t)tok0 * 1024 + c8 * 8;
#pragma unroll
        for (int k = 0; k < 3; ++k) { const int tt = t0 + k - 2; win[k + 1] = (tt >= 0 && tt < SEQ) ? *(const u32x4*)(src + (ptrdiff_t)(k - 2) * 1024) : zero4(); }
#pragma unroll
        for (int i = 0; i < 16; ++i) {
            win[0] = win[1]; win[1] = win[2]; win[2] = win[3];
            { const int tt = t0 + i + 1; win[3] = (tt < SEQ) ? *(const u32x4*)(src + (ptrdiff_t)(i + 1) * 1024) : zero4(); }
            float a[8];
#pragma unroll
            for (int e = 0; e < 8; ++e) a[e] = bia[e];
#pragma unroll
            for (int k = 0; k < 4; ++k) { const u32x4 xv = win[k];
                a[0] += wgt[k][0] * lo_bf(xv.x); a[1] += wgt[k][1] * hi_bf(xv.x); a[2] += wgt[k][2] * lo_bf(xv.y); a[3] += wgt[k][3] * hi_bf(xv.y);
                a[4] += wgt[k][4] * lo_bf(xv.z); a[5] += wgt[k][5] * hi_bf(xv.z); a[6] += wgt[k][6] * lo_bf(xv.w); a[7] += wgt[k][7] * hi_bf(xv.w); }
            u32x4 w; w.x = cvt_pk_bf16(a[0], a[1]); w.y = cvt_pk_bf16(a[2], a[3]); w.z = cvt_pk_bf16(a[4], a[5]); w.w = cvt_pk_bf16(a[6], a[7]);
            *(u32x4*)(xc + (size_t)(tok0 + i) * 512 + c8 * 8) = w;
        }
    }
}

__device__ void filter_finalize_phase() {
    unsigned char* ws = (unsigned char*)ldp(38);
    const float* hraw = (const float*)(ws + OFF_A + 160 * MiB); const float* norms = (const float*)(ws + OFF_SM); bf16_t* rv = (bf16_t*)(ws + OFF_YA);
    const int tid = TIDX, lane = tid & 63, gw = blockIdx.x * 8 + (tid >> 6), nw = gridDim.x * 8;
    for (int oc = gw; oc < 1024; oc += nw) {
        const int o = oc >> 9, c = oc & 511;
        float ns = norms[16384 + lane * 2048 + o * 512 + c] + norms[16384 + lane * 2048 + (2 + o) * 512 + c];
#pragma unroll
        for (int sft = 32; sft >= 1; sft >>= 1) ns += __shfl_xor(ns, sft);
        const float scale = 1.0f / (ns + 1e-6f);
        const float* kf = hraw + ((size_t)(0 * 2 + o) * 512 + c) * 2048; const float* kb = hraw + ((size_t)(1 * 2 + o) * 512 + c) * 2048;
        for (int it = 0; it < 8; ++it) { const int i0 = it * 512 + lane * 8; float v[8];
#pragma unroll
            for (int e = 0; e < 8; ++e) { const int d = 2048 - (i0 + e); float x = 0.f; if (d >= 0 && d <= 2047) x = kf[d]; else if (d < 0 && d >= -2047) x = kb[-d]; v[e] = x * scale; }
            u32x4 w; w.x = cvt_pk_bf16(v[0], v[1]); w.y = cvt_pk_bf16(v[2], v[3]); w.z = cvt_pk_bf16(v[4], v[5]); w.w = cvt_pk_bf16(v[6], v[7]);
            *(u32x4*)(rv + (size_t)oc * 4096 + i0) = w; }
    }
}

constexpr int ZS = 2056;
constexpr int FS = 4104;
__device__ void hyena_phase(unsigned char* smem, const Params& p, int l, int order) {
    bf16_t* zs = (bf16_t*)smem;
    bf16_t* fs = (bf16_t*)(smem + 16 * ZS * 2);
    unsigned char* ws = (unsigned char*)ldp(38);
    const bf16_t* hyT = (const bf16_t*)(ws + OFF_B); bf16_t* z1T = (bf16_t*)(ws + OFF_B + 96 * MiB); bf16_t* yaT = (bf16_t*)(ws + OFF_A);
    const bf16_t* rvp = (const bf16_t*)(ws + OFF_YA);
    const float* skip = ((const float*)ldp(17)) + (size_t)l * 2 * HYW + order * HYW;
    const int tid = TIDX, lane = tid & 63, w = tid >> 6, r16 = lane & 15, g4 = lane >> 4;
    for (int c = blockIdx.x; c < HYW; c += gridDim.x) {
        const bf16_t* zin = (order == 0) ? hyT + (size_t)c * NB * SEQ : z1T + (size_t)c * NB * SEQ;
        const bf16_t* gin = hyT + ((size_t)(order + 1) * HYW + c) * NB * SEQ;
        bf16_t* dst = (order == 0 ? z1T : yaT) + (size_t)c * NB * SEQ;
        const float sk = skip[c];
        __syncthreads();
        { const u32x4 rw = *(const u32x4*)(rvp + ((size_t)order * 512 + c) * 4096 + tid * 8);
          const unsigned short e[8] = {(unsigned short)(rw.x & 0xffff), (unsigned short)(rw.x >> 16), (unsigned short)(rw.y & 0xffff), (unsigned short)(rw.y >> 16),
                                       (unsigned short)(rw.z & 0xffff), (unsigned short)(rw.z >> 16), (unsigned short)(rw.w & 0xffff), (unsigned short)(rw.w >> 16)};
#pragma unroll
          for (int m = 0; m < 8; ++m) {
#pragma unroll
              for (int k = 0; k < 8; ++k) { const int x = tid * 8 + k - m; if (x >= 0) fs[m * FS + x] = e[k]; } } }
        for (int idx = tid; idx < 16 * 256; idx += 512) { const int b = idx >> 8, s8 = idx & 255; *(u32x4*)(zs + b * ZS + s8 * 8) = *(const u32x4*)(zin + (size_t)b * SEQ + s8 * 8); }
        __syncthreads();
        const int mcopy = (8 - (r16 & 7)) & 7;
        const bf16_t* fbase = fs + mcopy * FS - mcopy + 2048 - r16 + 8 * g4;
        const bf16_t* zbase = zs + r16 * ZS + 8 * g4;
        for (int mg = 0; mg < 2; ++mg) {
            const int tb = w * 256 + mg * 128;
            f32x4 acc[8];
#pragma unroll
            for (int mi = 0; mi < 8; ++mi) acc[mi] = (f32x4){0.f, 0.f, 0.f, 0.f};
            const bf16_t* fg = fbase - tb;
            bf16x8 W[8];
#pragma unroll
            for (int i = 0; i < 8; ++i) W[i] = *(const bf16x8*)(fg - 16 * i);
#pragma unroll 4
            for (int ks = 0; ks < 64; ++ks) {
                const bf16x8 bfr = *(const bf16x8*)(zbase + ks * 32);
                bf16x8 n0 = W[0], n1 = W[0];
                if (ks < 63) { n0 = *(const bf16x8*)(fg + 16 * (2 * ks + 2)); n1 = *(const bf16x8*)(fg + 16 * (2 * ks + 1)); }
#pragma unroll
                for (int mi = 0; mi < 8; ++mi) acc[mi] = __builtin_amdgcn_mfma_f32_16x16x32_bf16(W[mi], bfr, acc[mi], 0, 0, 0);
#pragma unroll
                for (int i = 7; i >= 2; --i) W[i] = W[i - 2];
                W[0] = n0; W[1] = n1;
            }
#pragma unroll
            for (int mi = 0; mi < 8; ++mi) { const int t = tb + mi * 16 + 4 * g4;
                const u32x2 gw = *(const u32x2*)(gin + (size_t)r16 * SEQ + t); const u32x2 zw = *(const u32x2*)(zs + r16 * ZS + t);
                const float gv[4] = {lo_bf(gw.x), hi_bf(gw.x), lo_bf(gw.y), hi_bf(gw.y)}; const float zv[4] = {lo_bf(zw.x), hi_bf(zw.x), lo_bf(zw.y), hi_bf(zw.y)};
                float o[4];
#pragma unroll
                for (int i = 0; i < 4; ++i) o[i] = gv[i] * (acc[mi][i] + sk * zv[i]);
                u32x2 wv; wv.x = cvt_pk_bf16(o[0], o[1]); wv.y = cvt_pk_bf16(o[2], o[3]); *(u32x2*)(dst + (size_t)r16 * SEQ + t) = wv; }
        }
    }
}

__device__ __forceinline__ float gelu_tanh_(float gx) { const float inner = 0.7978845608028654f * (gx + 0.044715f * gx * gx * gx); const float th = 1.0f - 2.0f * __builtin_amdgcn_rcpf(1.0f + __expf(2.0f * inner)); return 0.5f * gx * (1.0f + th); }
__device__ void rg_scan_phase(unsigned char* smem, const Params& p) {
    float* carr = (float*)smem;
    unsigned char* ws = (unsigned char*)ldp(38);
    const bf16_t* loga = (const bf16_t*)(ws + OFF_B); const bf16_t* uu = (const bf16_t*)(ws + OFF_B + 64 * MiB);
    const bf16_t* urg = (const bf16_t*)(ws + OFF_A + 96 * MiB); bf16_t* yc = (bf16_t*)(ws + OFF_YA); bf16_t* hfb = (bf16_t*)(ws + OFF_XC);
    const int tid = TIDX, cp = tid & 31, seg = tid >> 5;
    for (int tile = blockIdx.x; tile < NB * 8; tile += gridDim.x) {
        const int b = tile >> 3, j = (tile & 7) * 64 + 2 * cp;
        const size_t base = ((size_t)b * SEQ + seg * 128) * 512 + j;
        const bf16_t* la0 = loga + base; const bf16_t* u0 = uu + base; const bf16_t* la1 = loga + (size_t)MT * 512 + base; const bf16_t* u1 = uu + (size_t)MT * 512 + base;
        float A0x = 1.f, H0x = 0.f, A0y = 1.f, H0y = 0.f, A1x = 1.f, H1x = 0.f, A1y = 1.f, H1y = 0.f;
#pragma unroll 8
        for (int i = 0; i < 128; ++i) { const int tb = 127 - i;
            const unsigned l0 = *(const unsigned*)(la0 + (size_t)i * 512), v0 = *(const unsigned*)(u0 + (size_t)i * 512), l1 = *(const unsigned*)(la1 + (size_t)tb * 512), v1 = *(const unsigned*)(u1 + (size_t)tb * 512);
            const float a0x = __expf(lo_bf(l0)), a0y = __expf(hi_bf(l0)), a1x = __expf(lo_bf(l1)), a1y = __expf(hi_bf(l1));
            H0x = a0x * H0x + lo_bf(v0); A0x *= a0x; H0y = a0y * H0y + hi_bf(v0); A0y *= a0y;
            H1x = a1x * H1x + lo_bf(v1); A1x *= a1x; H1y = a1y * H1y + hi_bf(v1); A1y *= a1y; }
        __syncthreads();
        { float* c0 = carr + ((0 * 16 + seg) * 64 + 2 * cp) * 2; c0[0] = A0x; c0[1] = H0x; c0[2] = A0y; c0[3] = H0y;
          float* c1 = carr + ((1 * 16 + seg) * 64 + 2 * cp) * 2; c1[0] = A1x; c1[1] = H1x; c1[2] = A1y; c1[3] = H1y; }
        __syncthreads();
        float hfx = 0.f, hfy = 0.f, hbx = 0.f, hby = 0.f;
        for (int s = 0; s < seg; ++s) { const float* c0 = carr + ((0 * 16 + s) * 64 + 2 * cp) * 2; hfx = c0[0] * hfx + c0[1]; hfy = c0[2] * hfy + c0[3]; }
        for (int s = 15; s > seg; --s) { const float* c1 = carr + ((1 * 16 + s) * 64 + 2 * cp) * 2; hbx = c1[0] * hbx + c1[1]; hby = c1[2] * hby + c1[3]; }
        bf16_t* hfp = hfb + base;
#pragma unroll 8
        for (int i = 0; i < 128; ++i) { const unsigned l0 = *(const unsigned*)(la0 + (size_t)i * 512), v0 = *(const unsigned*)(u0 + (size_t)i * 512);
            hfx = __expf(lo_bf(l0)) * hfx + lo_bf(v0); hfy = __expf(hi_bf(l0)) * hfy + hi_bf(v0); *(unsigned*)(hfp + (size_t)i * 512) = cvt_pk_bf16(hfx, hfy); }
        const bf16_t* gp = urg + ((size_t)b * SEQ + seg * 128) * 1024 + 512 + j; bf16_t* yo = yc + ((size_t)b * SEQ + seg * 128) * 1536 + 1024 + j;
#pragma unroll 8
        for (int i = 0; i < 128; ++i) { const int tt = 127 - i; const unsigned l1 = *(const unsigned*)(la1 + (size_t)tt * 512), v1 = *(const unsigned*)(u1 + (size_t)tt * 512);
            hbx = __expf(lo_bf(l1)) * hbx + lo_bf(v1); hby = __expf(hi_bf(l1)) * hby + hi_bf(v1);
            const unsigned gw = *(const unsigned*)(gp + (size_t)tt * 1024), hw = *(const unsigned*)(hfp + (size_t)tt * 512);
            *(unsigned*)(yo + (size_t)tt * 1536) = cvt_pk_bf16((lo_bf(hw) + hbx) * gelu_tanh_(lo_bf(gw)), (hi_bf(hw) + hby) * gelu_tanh_(hi_bf(gw))); }
    }
}

constexpr int KST = 72, VSR = 72, AKR = 272;
typedef short s16x4 __attribute__((ext_vector_type(4)));
__device__ void attn_phase(unsigned char* smem, const Params& p, int chunk) {
    bf16_t* qkv = (bf16_t*)(((unsigned char*)ldp(38)) + OFF_A); float* lse = (float*)(((unsigned char*)ldp(38)) + OFF_XC);
    const float* biastab = (const float*)(((unsigned char*)ldp(38)) + OFF_SM) + 1024;
    const int tid = TIDX, lane = tid & 63, w = tid >> 6, half = w >> 2, qs = w & 3, r16 = lane & 15, g4 = lane >> 4;
    bf16_t* Ks = (bf16_t*)smem; bf16_t* Vs = (bf16_t*)(smem + AKR * KST * 2); float* bs = (float*)(smem + AKR * KST * 2 + AKR * VSR * 2);
    const int npair = NB * 24 * 32 / 2;
    u32x4 kreg[5], vreg[5]; bf16x8 qn[2]; float bn = 0.f;
#define ATT_DECODE(pr) const int tile0 = (pr) * 2; const int qb0 = tile0 & 31, hh = (tile0 >> 5) % 24, b = tile0 / (32 * 24); \
        const int grp = hh >> 3, dsh = 2 * grp, nbk = 32 >> dsh, Ls = SEQ >> dsh; const int res = qb0 / nbk, n0 = qb0 % nbk, n = n0 + half; const size_t brow = (size_t)b * SEQ;
#define ATT_PREFETCH(pr) do { ATT_DECODE(pr) \
        _Pragma("unroll") for (int it = 0; it < 5; ++it) { const int chunkid = tid + 512 * it; const int key = chunkid >> 3, part = chunkid & 7; const int kp = n0 * 64 + key - 64; \
            kreg[it] = zero4(); vreg[it] = kreg[it]; \
            if (chunkid < AKR * 8 && key < 256 && kp >= 0 && kp < Ls) { const size_t tok = brow + ((size_t)kp << dsh) + res; const bf16_t* src = qkv + tok * QKVC + hh * 64 + part * 8; kreg[it] = *(const u32x4*)(src + 1536); vreg[it] = *(const u32x4*)(src + 3072); } } \
        { const int qp = n * 64 + qs * 16 + r16; const size_t qtok = brow + ((size_t)qp << dsh) + res; \
          _Pragma("unroll") for (int ks = 0; ks < 2; ++ks) qn[ks] = *(const bf16x8*)(qkv + qtok * QKVC + hh * 64 + ks * 32 + g4 * 8); } \
        bn = (tid < 129) ? biastab[hh * 129 + tid] * 1.4426950408889634f : 0.f; } while (0)
    const int nrep = ((REP >> 5) & 1) + 1;
    int pair_ = blockIdx.x;
    if (pair_ < npair * nrep) ATT_PREFETCH(pair_ % npair);
    for (; pair_ < npair * nrep; pair_ += gridDim.x) { const int pair = pair_ % npair;
        ATT_DECODE(pair)
        __syncthreads();
#pragma unroll
        for (int it = 0; it < 5; ++it) { const int chunkid = tid + 512 * it; if (chunkid < AKR * 8) { const int key = chunkid >> 3, part = chunkid & 7;
            *(u32x4*)(Ks + key * KST + part * 8) = kreg[it]; *(u32x4*)(Vs + key * VSR + part * 8) = vreg[it]; } }
        if (tid < 129) bs[tid] = bn;
        bf16x8 qf[2]; qf[0] = qn[0]; qf[1] = qn[1];
        __syncthreads();
        if (pair_ + (int)gridDim.x < npair * nrep) ATT_PREFETCH((pair_ + (int)gridDim.x) % npair);
        const int hoff = 64 * half;
        const int qi = qs * 16 + r16; const int qp = n * 64 + qi; const size_t qtok = brow + ((size_t)qp << dsh) + res;
        int lo = -64, hi = 64;
        if (n == 0) lo = max(-64, -qi);
        if (n == nbk - 1) hi = min(64, 63 - qi);
        const int cbase = 4 * g4 - r16 - 64;
        const unsigned ub = (unsigned)(cbase - lo), rng = (unsigned)(hi - lo);
        const float* bl = bs + (cbase + 64);
        f32x4 s[10];
#pragma unroll
        for (int kt = 0; kt < 9; ++kt) { s[kt] = (f32x4){0.f, 0.f, 0.f, 0.f};
#pragma unroll
            for (int ks = 0; ks < 2; ++ks) { const bf16x8 kfr = *(const bf16x8*)(Ks + (hoff + qs * 16 + kt * 16 + r16) * KST + ks * 32 + g4 * 8); s[kt] = __builtin_amdgcn_mfma_f32_16x16x32_bf16(kfr, qf[ks], s[kt], 0, 0, 0); } }
        s[9] = (f32x4){0.f, 0.f, 0.f, 0.f};
        float mx = -1e30f;
#pragma unroll
        for (int kt = 0; kt < 9; ++kt)
#pragma unroll
            for (int i = 0; i < 4; ++i) { const bool valid = (ub + (unsigned)(16 * kt + i)) <= rng;
                const float v = valid ? __builtin_fmaf(s[kt][i], 0.125f * 1.4426950408889634f, bl[16 * kt + i]) : -1e30f; s[kt][i] = v; mx = fmaxf(mx, v); }
        mx = fmaxf(mx, __shfl_xor(mx, 16)); mx = fmaxf(mx, __shfl_xor(mx, 32));
        float den = 0.f;
#pragma unroll
        for (int kt = 0; kt < 9; ++kt)
#pragma unroll
            for (int i = 0; i < 4; ++i) { const float e = __builtin_amdgcn_exp2f(s[kt][i] - mx); s[kt][i] = e; den += e; }
        den += __shfl_xor(den, 16); den += __shfl_xor(den, 32);
        f32x4 o[4];
#pragma unroll
        for (int et = 0; et < 4; ++et) o[et] = (f32x4){0.f, 0.f, 0.f, 0.f};
        const bf16_t* vbase = Vs + (hoff + qs * 16 + 4 * g4 + (r16 >> 2)) * VSR + 4 * (r16 & 3);
#pragma unroll
        for (int cc = 0; cc < 5; ++cc) {
            union { u32x4 u; bf16x8 v; } pf; pf.u.x = cvt_pk_bf16(s[2 * cc][0], s[2 * cc][1]); pf.u.y = cvt_pk_bf16(s[2 * cc][2], s[2 * cc][3]);
            pf.u.z = cvt_pk_bf16(s[2 * cc + 1][0], s[2 * cc + 1][1]); pf.u.w = cvt_pk_bf16(s[2 * cc + 1][2], s[2 * cc + 1][3]);
#pragma unroll
            for (int et = 0; et < 4; ++et) { const bf16_t* vp = vbase + (cc * 32) * VSR + et * 16;
                const s16x4 v0 = __builtin_amdgcn_ds_read_tr16_b64_v4i16((LAS s16x4*)(LAS unsigned char*)vp), v1 = __builtin_amdgcn_ds_read_tr16_b64_v4i16((LAS s16x4*)(LAS unsigned char*)(vp + 16 * VSR));
                const bf16x8 vf = {v0[0], v0[1], v0[2], v0[3], v1[0], v1[1], v1[2], v1[3]};
                o[et] = __builtin_amdgcn_mfma_f32_16x16x32_bf16(vf, pf.v, o[et], 0, 0, 0); } }
        const float inv = __builtin_amdgcn_rcpf(den);
        bf16_t* op = qkv + qtok * QKVC + hh * 64 + 4 * g4;
#pragma unroll
        for (int et = 0; et < 4; ++et) { u32x2 wv; wv.x = cvt_pk_bf16(o[et][0] * inv, o[et][1] * inv); wv.y = cvt_pk_bf16(o[et][2] * inv, o[et][3] * inv); *(u32x2*)(op + et * 16) = wv; }
        if (g4 == 0) lse[qtok * 24 + hh] = mx * 0.6931471805599453f + logf(den);
    }
#undef ATT_DECODE
#undef ATT_PREFETCH
}

__device__ void attn_merge_phase(const Params& p, int chunk) {
    const bf16_t* og = (const bf16_t*)(((unsigned char*)ldp(38)) + OFF_A); const float* lse = (const float*)(((unsigned char*)ldp(38)) + OFF_XC); bf16_t* yb = (bf16_t*)(((unsigned char*)ldp(38)) + OFF_YA) + 512;
    const int total = MT * 64;
    for (int idx = blockIdx.x * 512 + TIDX; idx < total; idx += gridDim.x * 512) {
        const int e8 = idx & 7, j = (idx >> 3) & 7; const size_t tok = (size_t)(idx >> 6);
        const float l0 = lse[tok * 24 + j], l1 = lse[tok * 24 + 8 + j], l2 = lse[tok * 24 + 16 + j]; const float mx = fmaxf(l0, fmaxf(l1, l2));
        float w0 = __expf(l0 - mx), w1 = __expf(l1 - mx), w2 = __expf(l2 - mx); const float inv = 1.0f / (w0 + w1 + w2); w0 *= inv; w1 *= inv; w2 *= inv;
        const bf16_t* ob = og + tok * QKVC + j * 64 + e8 * 8;
        const u32x4 a = *(const u32x4*)ob, bq = *(const u32x4*)(ob + 512), cq = *(const u32x4*)(ob + 1024);
        u32x4 r;
        r.x = cvt_pk_bf16(w0 * lo_bf(a.x) + w1 * lo_bf(bq.x) + w2 * lo_bf(cq.x), w0 * hi_bf(a.x) + w1 * hi_bf(bq.x) + w2 * hi_bf(cq.x));
        r.y = cvt_pk_bf16(w0 * lo_bf(a.y) + w1 * lo_bf(bq.y) + w2 * lo_bf(cq.y), w0 * hi_bf(a.y) + w1 * hi_bf(bq.y) + w2 * hi_bf(cq.y));
        r.z = cvt_pk_bf16(w0 * lo_bf(a.z) + w1 * lo_bf(bq.z) + w2 * lo_bf(cq.z), w0 * hi_bf(a.z) + w1 * hi_bf(bq.z) + w2 * hi_bf(cq.z));
        r.w = cvt_pk_bf16(w0 * lo_bf(a.w) + w1 * lo_bf(bq.w) + w2 * lo_bf(cq.w), w0 * hi_bf(a.w) + w1 * hi_bf(bq.w) + w2 * hi_bf(cq.w));
        *(u32x4*)(yb + tok * 1536 + j * 64 + e8 * 8) = r;
    }
}

#define XB_TMO      128
#define XB_XCNT(j)  (256  + 64 * (j))
#define XB_XSUB(j)  (1280 + 64 * (j))
#define XB_XGEN(j)  (2304 + 64 * (j))
#define XB_TOP      3328
#define XB_TOPGEN   3392
#define XCD_BAR_WORDS 3456
#define XB_SPIN_CAP (1u << 22)
constexpr size_t OFF_BAR = OFF_SM + 640 * 1024;
__device__ __forceinline__ unsigned xb_ld(unsigned* p)              { return __hip_atomic_load(p, __ATOMIC_RELAXED, __HIP_MEMORY_SCOPE_AGENT); }
__device__ __forceinline__ unsigned xb_add(unsigned* p, unsigned v) { return __hip_atomic_fetch_add(p, v, __ATOMIC_RELAXED, __HIP_MEMORY_SCOPE_AGENT); }
__device__ __forceinline__ unsigned xb_xcc_id() { return (unsigned)__builtin_amdgcn_s_getreg((3 << 11) | 20) & 0xFu; }
#define XB_SPIN(cond, bar) do { unsigned _sp = 0; while (cond) { __builtin_amdgcn_s_sleep(1); \
    if ((++_sp & 255u) == 0u) { if (xb_ld(&(bar)[XB_TMO])) break; if (_sp > XB_SPIN_CAP) { atomicAdd(&(bar)[XB_TMO], 1u); break; } } } } while (0)
__device__ __forceinline__ void xcd_barrier_complete(unsigned* bar, unsigned x, unsigned& nloc, unsigned& nx) {
    const unsigned G = gridDim.x * gridDim.y * gridDim.z;
    unsigned sum, cnt, mine, sp = 0u;
    for (;;) {
        sum = 0u; cnt = 0u; mine = 0u;
#pragma unroll
        for (unsigned j = 0; j < 16; ++j) { const unsigned c = xb_ld(&bar[XB_XCNT(j)]); sum += c; cnt += (c > 0u) ? 1u : 0u; mine = (j == x) ? c : mine; }
        if (sum == G) break;
        __builtin_amdgcn_s_sleep(1);
        if ((++sp & 255u) == 0u) { if (xb_ld(&bar[XB_TMO])) break; if (sp > XB_SPIN_CAP) { atomicAdd(&bar[XB_TMO], 1u); break; } }
    }
    nloc = mine > 0u ? mine : 1u; nx = cnt > 0u ? cnt : 1u;
}
__device__ __forceinline__ void xcd_barrier() {
    asm volatile("s_waitcnt vmcnt(0)" ::: "memory");
    __syncthreads();
    if (threadIdx.x == 0) {
        unsigned* bar = (unsigned*)(((unsigned char*)ldp(38)) + OFF_BAR);
        volatile LAS unsigned* st = (volatile LAS unsigned*)(LAS unsigned char*)(g_smem + LDS_BYTES - 1024);
        const unsigned x = xb_xcc_id();
        __builtin_amdgcn_s_waitcnt(0);
        unsigned nloc = st[0], nx = st[1];
        if (nloc == 0u) { xcd_barrier_complete(bar, x, nloc, nx); st[0] = nloc; st[1] = nx; }
        const unsigned old = xb_add(&bar[XB_XSUB(x)], 1u);
        const unsigned gen = old / nloc;
        if (old + 1u == (gen + 1u) * nloc) {
            __builtin_amdgcn_fence(__ATOMIC_RELEASE, "agent");
            asm volatile("s_waitcnt vmcnt(0)" ::: "memory");
            const unsigned og = xb_add(&bar[XB_TOP], 1u);
            const unsigned tg = og / nx;
            if (og + 1u == (tg + 1u) * nx) xb_add(&bar[XB_TOPGEN], 1u);
            else XB_SPIN(xb_ld(&bar[XB_TOPGEN]) == tg, bar);
            __builtin_amdgcn_fence(__ATOMIC_ACQUIRE, "agent");
            xb_add(&bar[XB_XGEN(x)], 1u);
            asm volatile("s_waitcnt vmcnt(0)" ::: "memory");
        } else {
            XB_SPIN(xb_ld(&bar[XB_XGEN(x)]) == gen, bar);
            __builtin_amdgcn_fence(__ATOMIC_ACQUIRE, "agent");
            asm volatile("s_waitcnt vmcnt(0)" ::: "memory");
        }
    }
    __syncthreads();
}

__global__ void __launch_bounds__(512, 2) fwd_megakernel(Params p) {
    extern __shared__ __attribute__((aligned(16))) unsigned char smem[];
    if (threadIdx.x == 0) { unsigned long long* tb = (unsigned long long*)(smem + PTR_OFF);
#pragma unroll
        for (int i = 0; i < 37; ++i) tb[i] = (unsigned long long)p.in[i];
        tb[37] = (unsigned long long)p.out; tb[38] = (unsigned long long)p.ws; }
    if (threadIdx.x == 0) { volatile LAS unsigned* st = (volatile LAS unsigned*)(LAS unsigned char*)(smem + LDS_BYTES - 1024); st[0] = 0u; st[1] = 0u;
        (void)xb_add(&((unsigned*)(p.ws + OFF_BAR))[XB_XCNT(xb_xcc_id())], 1u); }
    __syncthreads();
    bf16_t* wt = (bf16_t*)(((unsigned char*)ldp(38)) + OFF_WT); bf16_t* xn = (bf16_t*)(((unsigned char*)ldp(38)) + OFF_XN); float* h = ((float*)ldp(37));
    float* part = (float*)(((unsigned char*)ldp(38)) + OFF_PART);
    unsigned char* RA = ((unsigned char*)ldp(38)) + OFF_A; unsigned char* RB = ((unsigned char*)ldp(38)) + OFF_B;
    constexpr int NSTEP = 20;
    for (int it = 0; it <= DEPTH * NSTEP; ++it) {
        const int l = it / NSTEP, s = it - l * NSTEP;
        if (l == DEPTH) { rmsnorm_phase(h, ((const float*)ldp(36)), nullptr, nullptr, h); break; }
        GDesc d; d.kind = -1; d.A = nullptr; d.Bt = nullptr; d.M = MT; d.N = 0; d.K = 1024; d.p0 = nullptr; d.p1 = nullptr; d.q0 = nullptr; d.q1 = nullptr; d.q2 = nullptr; d.q3 = nullptr; d.i0 = 0; d.i1 = 0; d.i2 = 0; d.f0 = 0.f;
        bool sync = true;
        switch (s) {
        case 0: convert_phase(smem, p, l); filter_mlp_phase(smem, l); if (l == 0) prep_phase((const float*)ldp(0), h, xn, part); break;
        case 3: case 17: sync = false; break;
        case 1: case 18: d.kind = 0; d.A = xn; d.Bt = wt + (s == 1 ? W_UP1 : W_UP2); d.N = 5632; d.K = 1024; d.p0 = RA; d.q3 = part; break;
        case 2: case 19: d.kind = 1; d.A = (const bf16_t*)RA; d.Bt = wt + (s == 2 ? W_DN1 : W_DN2); d.N = 1024; d.K = 2816; d.p0 = h; d.f0 = 0.5f; d.p1 = xn; d.q3 = part; break;
        case 4: d.kind = 2; d.A = xn; d.Bt = wt + W_HYRG; d.N = 2560; d.K = 1024; d.p0 = RA; d.i0 = HYC; d.p1 = RA + 96 * MiB; d.i1 = 1024; d.i2 = HYC; d.q3 = part; sync = false; break;
        case 5: RP(2) filter_phase(smem, p, l); break;
        case 6: filter_finalize_phase(); RP(3) { hy_transpose_phase(smem, p, l); rg_conv_phase(p, l); } break;
        case 7: case 8: RP(4) hyena_phase(smem, p, l, s - 7); break;
        case 9: d.kind = 7; d.A = (const bf16_t*)(((unsigned char*)ldp(38)) + OFF_XC); d.Bt = wt + W_RG; d.N = 2048; d.K = 512; d.q0 = ((unsigned char*)ldp(38)) + OFF_XC; d.p0 = RB; d.p1 = RB + 64 * MiB;
                d.q1 = ((const float*)ldp(22)) + l * 1024; d.q2 = ((const float*)ldp(24)) + l * 1024; d.q3 = (const float*)(((unsigned char*)ldp(38)) + OFF_SM) + 4224; break;
        case 10: if (gridDim.x >= 256 && blockIdx.x >= 128) ya_transpose_phase(smem, 128, (int)gridDim.x - 128); else { if (gridDim.x < 256) ya_transpose_phase(smem, 0, (int)gridDim.x); RP(13) rg_scan_phase(smem, p); } break;
        case 11: d.kind = 2; d.A = xn; d.Bt = wt + W_QKV; d.N = QKVC; d.K = 1024; d.p0 = RA; d.i0 = QKVC; d.p1 = RA; d.i1 = QKVC; d.i2 = 1 << 30; d.q3 = part; break;
        case 12: attn_phase(smem, p, 0); break;
        case 13: RP(6) attn_merge_phase(p, 0); break;
        case 14: d.kind = 3; d.A = xn; d.Bt = wt + W_GATE; d.N = 3072; d.K = 1024; d.p0 = RA; d.q0 = ((const float*)ldp(27)) + l * 3072; d.q3 = part; break;
        case 15: d.kind = 4; d.A = (const bf16_t*)(((unsigned char*)ldp(38)) + OFF_YA); d.Bt = wt + W_PCAT; d.N = 1024; d.K = 1536; d.q0 = RA; d.p1 = RA + 192 * MiB; break;
        case 16: d.kind = 1; d.A = (const bf16_t*)(RA + 192 * MiB); d.Bt = wt + W_OUT; d.N = 1024; d.K = 1024; d.p0 = h; d.f0 = 1.0f; d.p1 = xn; d.q3 = part; break;
        default: break;
        }
        if (d.kind >= 0) { run_gemm(smem, d); if ((REP >> 7) & 1) { if (s == 1 || s == 18) run_gemm(smem, d); } if ((REP >> 8) & 1) { if (s == 9) run_gemm(smem, d); } if ((REP >> 9) & 1) { if (s == 14 || s == 11 || s == 4 || s == 15) run_gemm(smem, d); } }
        if (sync) { if (it == 0) cg::this_grid().sync(); else xcd_barrier(); if ((REP >> 12) & 1) xcd_barrier(); }
    }
}

extern "C" void kernel_launch(void* const* d_in, const int* in_sizes, int n_in, void* d_out, int out_size, void* d_ws, size_t ws_size, hipStream_t stream) {
    static int grid_blocks = 0;
    if (grid_blocks == 0) {
        if (n_in != 37 || out_size != MT * DM || ws_size < WS_NEED) { fprintf(stderr, "kernel_launch: unexpected shapes / workspace (%d inputs, out %d, ws %zu, need %zu)\n", n_in, out_size, ws_size, (size_t)WS_NEED); grid_blocks = -1; return; }
        int dev = 0, cus = 0, per_cu = 0;
        hipGetDevice(&dev); hipDeviceGetAttribute(&cus, hipDeviceAttributeMultiprocessorCount, dev);
        if (hipFuncSetAttribute((const void*)fwd_megakernel, hipFuncAttributeMaxDynamicSharedMemorySize, LDS_BYTES) != hipSuccess) { fprintf(stderr, "kernel_launch: hipFuncSetAttribute failed\n"); grid_blocks = -1; return; }
        if (hipOccupancyMaxActiveBlocksPerMultiprocessor(&per_cu, (const void*)fwd_megakernel, 512, LDS_BYTES) != hipSuccess || per_cu < 1) per_cu = 1;
        (void)hipGetLastError();
        grid_blocks = cus * 1;
    }
    if (grid_blocks < 0) return;
    Params p{};
    for (int i = 0; i < 37; ++i) p.in[i] = (const float*)d_in[i];
    p.out = (float*)d_out; p.ws = (unsigned char*)d_ws;
    if (hipMemsetAsync((unsigned char*)d_ws + OFF_BAR, 0, XCD_BAR_WORDS * 4, stream) != hipSuccess) { fprintf(stderr, "kernel_launch: memset failed\n"); return; }
    void* args[] = {&p};
    hipError_t e = hipLaunchCooperativeKernel((const void*)fwd_megakernel, dim3(grid_blocks), dim3(512), args, LDS_BYTES, stream);
    if (e != hipSuccess) fprintf(stderr, "cooperative launch failed: %s (grid %d)\n", hipGetErrorString(e), grid_blocks);
}
```
